# Optimizing an MI355X kernel written in HIP

```python
import jax, jax.numpy as jnp
from jax import lax
import numpy as np

D_MODEL = 1024
BATCH = 16
SEQ = 2048
DEPTH = 4

CONV_W = 512
CONV_K = 3
N_HEADS = 8
HEAD_DIM = 64
N_KV = 2
HPG = N_HEADS // N_KV
ATTN_W = N_HEADS * HEAD_DIM
KV_W = N_KV * HEAD_DIM
CMP_L = 32
CMP_D = 16
CMP_HIDDEN = 4 * HEAD_DIM
SEL_L = 64
N_SEL = 8
WINDOW = 512
Q_BLOCK = 128
FORCE_BONUS = 1e4
NEG = -1e30
D_FF = 4 * D_MODEL
ROPE_THETA = 10000.0
EPS = 1e-6
POS_OFFSET_MAX = 1024
IN_SIZES = (CONV_W, CONV_W, CONV_W, ATTN_W, KV_W, KV_W, KV_W, KV_W, KV_W, KV_W, 3 * N_HEADS, 2 * D_MODEL)
IN_W = sum(IN_SIZES)

kernel_name = "hybrid_conv_nsa_adaln_trunk"


def rmsnorm(x, g):
    xf = x.astype(jnp.float32)
    y = xf * lax.rsqrt(jnp.mean(xf * xf, axis=-1, keepdims=True) + EPS)
    return (y * g.astype(jnp.float32)).astype(x.dtype)


def rope_tables(positions):
    half = HEAD_DIM // 2
    inv_freq = ROPE_THETA ** (-jnp.arange(half, dtype=jnp.float32) * 2.0 / HEAD_DIM)
    ang = positions.astype(jnp.float32)[..., None] * inv_freq
    return jnp.cos(ang)[:, :, None, :], jnp.sin(ang)[:, :, None, :]


def apply_rope(x, cos, sin):
    half = HEAD_DIM // 2
    xf = x.astype(jnp.float32)
    x1, x2 = xf[..., :half], xf[..., half:]
    return jnp.concatenate([x1 * cos - x2 * sin, x2 * cos + x1 * sin], axis=-1).astype(x.dtype)


def masked_softmax(s, mask):
    s = jnp.where(mask, s.astype(jnp.float32), NEG)
    p = jax.nn.softmax(s, axis=-1)
    return jnp.where(mask, p, 0.0)


def short_conv_mixer(b_gate, c_gate, u, conv_w):
    v = c_gate * u
    w = conv_w.reshape(CONV_K, 1, CONV_W).astype(v.dtype)
    y = lax.conv_general_dilated(v, w, window_strides=(1,), padding=[(CONV_K - 1, 0)],
                                 dimension_numbers=('NWC', 'WIO', 'NWC'),
                                 feature_group_count=CONV_W)
    return b_gate * y


def compress_blocks(k, w1, w2, pe):
    B, S = k.shape[0], k.shape[1]
    nc = (S - CMP_L) // CMP_D + 1
    idx = np.arange(nc)[:, None] * CMP_D + np.arange(CMP_L)[None, :]
    blocks = jnp.swapaxes(k[:, idx], 2, 3) + pe
    flat = blocks.reshape(B, nc, N_KV, CMP_L * HEAD_DIM)
    return jax.nn.silu(flat @ w1) @ w2


def nsa_mixer(q, kc, vc, ks, vs, kw, vw, gate_logits, ck_w1, ck_w2, ck_pe, cv_w1, cv_w2, cv_pe):
    B, S = q.shape[0], q.shape[1]
    scale = HEAD_DIM ** -0.5
    qg = q.reshape(B, S, N_KV, HPG, HEAD_DIM)
    t = jnp.arange(S)

    kcmp = compress_blocks(kc, ck_w1, ck_w2, ck_pe)
    vcmp = compress_blocks(vc, cv_w1, cv_w2, cv_pe)
    nc = kcmp.shape[1]
    cstart = jnp.arange(nc) * CMP_D
    cmp_mask = (cstart + CMP_L - 1)[None, :] <= t[:, None]
    s_cmp = jnp.einsum('bsghd,bcgd->bsghc', qg, kcmp).astype(jnp.float32) * scale
    p_cmp = masked_softmax(s_cmp, cmp_mask[None, :, None, None, :])
    o_cmp = jnp.einsum('bsghc,bcgd->bsghd', p_cmp.astype(q.dtype), vcmp)

    ns = S // SEL_L
    j = jnp.arange(ns)
    overlap = ((cstart[:, None] < (j[None, :] + 1) * SEL_L) &
               (cstart[:, None] + CMP_L > j[None, :] * SEL_L)).astype(jnp.float32)
    imp = jnp.einsum('bsgc,cn->bsgn', p_cmp.sum(axis=3), overlap)
    blk_t = t // SEL_L
    valid = (j[None, :] <= blk_t[:, None])[:, None, :]
    forced = ((j[None, :] == 0) | (j[None, :] == blk_t[:, None]) | (j[None, :] == blk_t[:, None] - 1))[:, None, :]
    imp = jnp.where(valid, imp + FORCE_BONUS * forced.astype(jnp.float32), -1.0)
    n_sel = min(N_SEL, ns)
    _, sel_idx = lax.top_k(imp, n_sel)

    ks_blk = ks.reshape(B, ns, SEL_L, N_KV, HEAD_DIM).transpose(0, 3, 1, 2, 4)
    vs_blk = vs.reshape(B, ns, SEL_L, N_KV, HEAD_DIM).transpose(0, 3, 1, 2, 4)
    pad = ((0, 0), (WINDOW, 0), (0, 0), (0, 0))
    kw_pad = jnp.pad(kw, pad)
    vw_pad = jnp.pad(vw, pad)
    gather = jax.vmap(jax.vmap(lambda blk, ids: blk[ids]))

    def block_fn(qb):
        start = qb * Q_BLOCK
        q_b = lax.dynamic_slice_in_dim(qg, start, Q_BLOCK, 1)
        tq = start + jnp.arange(Q_BLOCK)
        ids = lax.dynamic_slice_in_dim(sel_idx, start, Q_BLOCK, 1).transpose(0, 2, 1, 3)
        ids_flat = ids.reshape(B, N_KV, Q_BLOCK * n_sel)
        k_sel = gather(ks_blk, ids_flat).reshape(B, N_KV, Q_BLOCK, n_sel * SEL_L, HEAD_DIM)
        v_sel = gather(vs_blk, ids_flat).reshape(B, N_KV, Q_BLOCK, n_sel * SEL_L, HEAD_DIM)
        kpos = (ids[..., None] * SEL_L + jnp.arange(SEL_L)).reshape(B, N_KV, Q_BLOCK, n_sel * SEL_L)
        m_sel = (kpos <= tq[None, None, :, None]).transpose(0, 2, 1, 3)[:, :, :, None, :]
        s_sel = jnp.einsum('bqghd,bgqkd->bqghk', q_b, k_sel).astype(jnp.float32) * scale
        p_sel = masked_softmax(s_sel, m_sel)
        o_sel = jnp.einsum('bqghk,bgqkd->bqghd', p_sel.astype(q.dtype), v_sel)
        k_w = lax.dynamic_slice_in_dim(kw_pad, start, Q_BLOCK + WINDOW, 1)
        v_w = lax.dynamic_slice_in_dim(vw_pad, start, Q_BLOCK + WINDOW, 1)
        kpos_w = start - WINDOW + jnp.arange(Q_BLOCK + WINDOW)
        m_w = ((kpos_w[None, :] <= tq[:, None]) & (kpos_w[None, :] > tq[:, None] - WINDOW)
               & (kpos_w[None, :] >= 0))
        s_w = jnp.einsum('bqghd,bkgd->bqghk', q_b, k_w).astype(jnp.float32) * scale
        p_w = masked_softmax(s_w, m_w[None, :, None, None, :])
        o_w = jnp.einsum('bqghk,bkgd->bqghd', p_w.astype(q.dtype), v_w)
        return o_sel, o_w

    o_sel, o_w = lax.map(block_fn, jnp.arange(S // Q_BLOCK))
    o_sel = jnp.swapaxes(o_sel, 0, 1).reshape(B, S, N_KV, HPG, HEAD_DIM)
    o_w = jnp.swapaxes(o_w, 0, 1).reshape(B, S, N_KV, HPG, HEAD_DIM)
    g = jax.nn.sigmoid(gate_logits).reshape(B, S, 3, N_KV, HPG)[..., None]
    o = g[:, :, 0] * o_cmp + g[:, :, 1] * o_sel + g[:, :, 2] * o_w
    return o.reshape(B, S, ATTN_W)


def setup_inputs(seed: int = 0) -> dict:
    key = jax.random.key(seed)
    ks = jax.random.split(key, 24)
    nrm = lambda k, shape, s: jax.random.normal(k, shape, jnp.float32) * s
    offs = jax.random.randint(ks[2], (BATCH, 1), 0, POS_OFFSET_MAX, dtype=jnp.int32)
    positions = (offs + jnp.arange(SEQ, dtype=jnp.int32)[None, :]).astype(jnp.int32)
    return {
        "x": nrm(ks[0], (BATCH, SEQ, D_MODEL), 1.0),
        "c": nrm(ks[1], (BATCH, D_MODEL), 1.0),
        "positions": positions,
        "w_ada": nrm(ks[3], (DEPTH, D_MODEL, 6 * D_MODEL), D_MODEL ** -0.5),
        "b_ada": nrm(ks[4], (DEPTH, 6 * D_MODEL), 0.01),
        "g_mix": 1.0 + nrm(ks[5], (DEPTH, D_MODEL), 0.02),
        "w_in": nrm(ks[6], (DEPTH, D_MODEL, IN_W), D_MODEL ** -0.5),
        "b_in": nrm(ks[7], (DEPTH, IN_W), 0.01),
        "conv_w": nrm(ks[8], (DEPTH, CONV_K, CONV_W), CONV_K ** -0.5),
        "cmp_k_w1": nrm(ks[9], (DEPTH, CMP_L * HEAD_DIM, CMP_HIDDEN), (CMP_L * HEAD_DIM) ** -0.5),
        "cmp_k_w2": nrm(ks[10], (DEPTH, CMP_HIDDEN, HEAD_DIM), CMP_HIDDEN ** -0.5),
        "cmp_k_pe": nrm(ks[11], (DEPTH, CMP_L, HEAD_DIM), 0.1),
        "cmp_v_w1": nrm(ks[12], (DEPTH, CMP_L * HEAD_DIM, CMP_HIDDEN), (CMP_L * HEAD_DIM) ** -0.5),
        "cmp_v_w2": nrm(ks[13], (DEPTH, CMP_HIDDEN, HEAD_DIM), CMP_HIDDEN ** -0.5),
        "cmp_v_pe": nrm(ks[14], (DEPTH, CMP_L, HEAD_DIM), 0.1),
        "w_up_conv": nrm(ks[15], (DEPTH, CONV_W, D_MODEL), CONV_W ** -0.5),
        "w_up_attn": nrm(ks[16], (DEPTH, ATTN_W, D_MODEL), ATTN_W ** -0.5),
        "w_o": nrm(ks[17], (DEPTH, D_MODEL, D_MODEL), D_MODEL ** -0.5),
        "g_mlp": 1.0 + nrm(ks[18], (DEPTH, D_MODEL), 0.02),
        "w_ff1": nrm(ks[19], (DEPTH, D_MODEL, D_FF), D_MODEL ** -0.5),
        "w_ff2": nrm(ks[20], (DEPTH, D_FF, D_MODEL), D_FF ** -0.5),
        "g_final": 1.0 + nrm(ks[21], (D_MODEL,), 0.02),
    }


def reference(x, c, positions, w_ada, b_ada, g_mix, w_in, b_in, conv_w, cmp_k_w1, cmp_k_w2, cmp_k_pe,
              cmp_v_w1, cmp_v_w2, cmp_v_pe, w_up_conv, w_up_attn, w_o, g_mlp, w_ff1, w_ff2, g_final):
    B, S, _ = x.shape
    cos, sin = rope_tables(positions)
    split_at = [int(v) for v in np.cumsum(IN_SIZES)[:-1]]
    c_act = jax.nn.silu(c)
    for l in range(DEPTH):
        cond = c_act @ w_ada[l] + b_ada[l]
        sh_a, sc_a, ga_a, sh_m, sc_m, ga_m = [v[:, None, :] for v in jnp.split(cond, 6, axis=-1)]

        h = rmsnorm(x, g_mix[l]) * (1.0 + sc_a) + sh_a
        z = h @ w_in[l] + b_in[l]
        (cb, cc, cu, q, kc, vc, k_s, v_s, k_w, v_w, nsa_g, merge_g) = jnp.split(z, split_at, axis=-1)
        y_conv = short_conv_mixer(cb, cc, cu, conv_w[l]) @ w_up_conv[l]
        q = apply_rope(q.reshape(B, S, N_HEADS, HEAD_DIM), cos, sin)
        kv = lambda a: a.reshape(B, S, N_KV, HEAD_DIM)
        kc = apply_rope(kv(kc), cos, sin)
        k_s = apply_rope(kv(k_s), cos, sin)
        k_w = apply_rope(kv(k_w), cos, sin)
        y_attn = nsa_mixer(q, kc, kv(vc), k_s, kv(v_s), k_w, kv(v_w), nsa_g,
                           cmp_k_w1[l], cmp_k_w2[l], cmp_k_pe[l],
                           cmp_v_w1[l], cmp_v_w2[l], cmp_v_pe[l]) @ w_up_attn[l]
        g_conv, g_attn = jnp.split(jax.nn.sigmoid(merge_g), 2, axis=-1)
        mixed = (g_conv * y_conv + g_attn * y_attn) @ w_o[l]
        x = x + ga_a * mixed

        h = rmsnorm(x, g_mlp[l]) * (1.0 + sc_m) + sh_m
        x = x + ga_m * (jnp.square(jax.nn.relu(h @ w_ff1[l])) @ w_ff2[l])
    return rmsnorm(x, g_final)
```

```cpp
#include <hip/hip_runtime.h>
#include <cstdio>
#include <cstdint>
namespace pg8 {
#define PG8_LAS __attribute__((address_space(3)))
typedef unsigned short bf16_t;
typedef short bf16x8 __attribute__((ext_vector_type(8)));
typedef float f32x4 __attribute__((ext_vector_type(4)));
typedef unsigned u32x4 __attribute__((ext_vector_type(4)));
constexpr int BM = 256, BK = 64, HALF = 128, HTB = HALF * BK * 2  , STAGE_BYTES = 8 * HTB, NXCD = 8, WGM = 4;

__host__ __device__ __forceinline__ int lds_byte(int r, int c) { const int st = (r >> 4) * 2 + (c >> 5), rr = r & 15, cc = c & 31, ob = rr * 64 + cc * 2; return st * 1024 + (ob ^ (((ob >> 9) & 1) << 5)); }
__host__ __device__ __forceinline__ void stage_rc(int b, int& R, int& C) { const int st = b / 1024, sb = b % 1024, swz = sb ^ (((sb >> 9) & 1) << 5); R = (st >> 1) * 16 + swz / 64; C = (st & 1) * 32 + (swz % 64) / 2; }
__host__ __device__ __forceinline__ int perm32(int rho) { const int n = rho >> 4, i = rho & 15; return 8 * (i >> 2) + 4 * n + (i & 3); }

struct Unit { int pm, pn; };
struct Gemm { const __attribute__((address_space(1))) bf16_t* A; const __attribute__((address_space(1))) bf16_t* Bt; int M, N, K, lda, ldb; size_t a_kstep = 0, a_hstep = 0, a_tstep = 0, a_bextra = 0; };

struct StaticOrder {
    int nM, nN, nwg, G, c, pm0;
    __host__ __device__ void init(int nM_, int N, int G_, int c_, int pm0_) { nM = nM_; nN = N / BM; nwg = nM * nN; G = G_; c = c_; pm0 = pm0_; }
    __host__ __device__ bool next(int i, Unit& u) const {
        const long L = (long)i * G + c; if (L >= nwg) return false;
        const int wgid = (int)L;
        const int nig = WGM * nN, gid = wgid / nig, fm = gid * WGM, gsz = (nM - fm) < WGM ? (nM - fm) : WGM;
        u.pm = pm0 + fm + ((wgid % nig) % gsz); u.pn = (wgid % nig) / gsz; return true;
    }
    __device__ __forceinline__ void a_ready(const Unit&) const {}
    __device__ __forceinline__ void done(const Unit&) const {}
};

typedef float cvt_f2 __attribute__((ext_vector_type(2)));
typedef __bf16 cvt_b2 __attribute__((ext_vector_type(2)));
__device__ __forceinline__ unsigned cvt_pk_bf16(float lo, float hi) { const cvt_f2 v = {lo, hi}; const cvt_b2 r = __builtin_convertvector(v, cvt_b2); return __builtin_bit_cast(unsigned, r); }
template <class Epi, class Sched, bool ALIGN_EPI = false, bool SP2 = false>
__device__ __forceinline__ void gemm_phase(PG8_LAS unsigned char* lds, const Gemm g, const Sched& S, const Epi& E, int wave_in) {
    unsigned ones_ = ~0u; asm volatile("" : "+s"(ones_));
    int tid_ = (wave_in << 6) | (int)__builtin_amdgcn_mbcnt_hi(ones_, __builtin_amdgcn_mbcnt_lo(ones_, 0u)); asm volatile("" : "+v"(tid_));
    const int tid = tid_, wid = __builtin_amdgcn_readfirstlane(tid >> 6), lane = tid & 63, wr = wid >> 2, wc = wid & 3, fr = lane & 15, fq = lane >> 4;
    const int K = g.K, nt = K / BK;
    unsigned voffA[2], voffB[2];
#pragma unroll
    for (int i = 0; i < 2; ++i) { int R, C; stage_rc(tid * 16 + i * 8192, R, C); const int Rb = Epi::PERM ? ((R & ~31) + perm32(R & 31)) : R;
        voffA[i] = (unsigned)(R * g.lda + C) * 2u; voffB[i] = (unsigned)(Rb * g.ldb + C) * 2u; }
    const size_t kstepB = (size_t)(BK * 2), kstepA = g.a_kstep ? g.a_kstep : kstepB;
    const size_t hstepA = g.a_hstep ? g.a_hstep : (size_t)HALF * g.lda * 2, hstepB = (size_t)HALF * g.ldb * 2;
    const size_t tstepA = g.a_tstep ? g.a_tstep : 2 * hstepA, tstepB = 2 * hstepB;
    const unsigned ldsw = (unsigned)wid * 1024u;
    const int aoff = lds_byte(wr * 64 + fr, fq * 8), boff = lds_byte(wc * 32 + fr, fq * 8);
#define PG8_SA(b, h) (((b) * 2 + (h)) * HTB)
#define PG8_SB(b, h) ((4 + (b) * 2 + (h)) * HTB)
#define PG8_STAGE(bufoff, gbase, voff) do { _Pragma("unroll") for (int _i = 0; _i < 2; ++_i) \
        __builtin_amdgcn_global_load_lds((const unsigned*)((const char*)(gbase) + (voff)[_i]), (PG8_LAS unsigned*)(lds + (bufoff) + ldsw + _i * 8192), 16, 0, 0); } while (0)
#define PG8_LDA(dst, b, h) do { _Pragma("unroll") for (int m = 0; m < 4; ++m) _Pragma("unroll") for (int k = 0; k < 2; ++k) dst[m][k] = *(const PG8_LAS bf16x8*)(lds + PG8_SA(b, h) + aoff + m * 2048 + k * 1024); } while (0)
#define PG8_LDB(dst, b, h) do { _Pragma("unroll") for (int n = 0; n < 2; ++n) _Pragma("unroll") for (int k = 0; k < 2; ++k) dst[n][k] = *(const PG8_LAS bf16x8*)(lds + PG8_SB(b, h) + boff + n * 2048 + k * 1024); } while (0)
#define PG8_MMA(ai, bj, At, Bt) do { __builtin_amdgcn_s_setprio(1); _Pragma("unroll") for (int m = 0; m < 4; ++m) _Pragma("unroll") for (int n = 0; n < 2; ++n) _Pragma("unroll") for (int k = 0; k < 2; ++k) \
        acc[ai][bj][m][n] = __builtin_amdgcn_mfma_f32_16x16x32_bf16(Bt[n][k], At[m][k], acc[ai][bj][m][n], 0, 0, 0); __builtin_amdgcn_s_setprio(0); } while (0)
#define PG8_WAIT_V(n) asm volatile("s_waitcnt vmcnt(" #n ")" ::: "memory")
#define PG8_WAIT_L(n) asm volatile("s_waitcnt lgkmcnt(" #n ")" ::: "memory")
#define PG8_BAR __builtin_amdgcn_s_barrier()
#define PG8_SCHED __builtin_amdgcn_sched_barrier(0)
    Unit cur, nxt; int ui = 0;
    if (!S.next(0, cur)) return;
    f32x4 acc[2][2][4][2];
#pragma unroll
    for (int a = 0; a < 2; ++a)
#pragma unroll
        for (int b = 0; b < 2; ++b)
#pragma unroll
            for (int m = 0; m < 4; ++m)
#pragma unroll
                for (int n = 0; n < 2; ++n) acc[a][b][m][n] = (f32x4){0.f, 0.f, 0.f, 0.f};
    bf16x8 At[4][2], B0[2][2], B1[2][2];
    const char* cA = (const char*)g.A + (size_t)cur.pm * tstepA + (size_t)(cur.pm >> 3) * g.a_bextra; const char* cB = (const char*)g.Bt + (size_t)cur.pn * tstepB;
    S.a_ready(cur);
    if constexpr (SP2) {
        PG8_STAGE(PG8_SB(0, 0), cB, voffB); PG8_STAGE(PG8_SB(0, 1), cB + hstepB, voffB); PG8_STAGE(PG8_SA(0, 0), cA, voffA); PG8_STAGE(PG8_SA(0, 1), cA + hstepA, voffA);
        if (wr == 1) PG8_BAR;
        PG8_WAIT_V(2); PG8_BAR;
        PG8_STAGE(PG8_SB(1, 0), cB + kstepB, voffB); PG8_STAGE(PG8_SA(1, 0), cA + kstepA, voffA); PG8_STAGE(PG8_SB(1, 1), cB + hstepB + kstepB, voffB);
        PG8_WAIT_V(6); PG8_BAR;
    } else {
        PG8_STAGE(PG8_SB(0, 0), cB, voffB); PG8_STAGE(PG8_SA(0, 0), cA, voffA); PG8_STAGE(PG8_SB(0, 1), cB + hstepB, voffB); PG8_STAGE(PG8_SA(0, 1), cA + hstepA, voffA);
        if (wr == 1) PG8_BAR;
        PG8_WAIT_V(4); PG8_BAR;
        PG8_STAGE(PG8_SB(1, 0), cB + kstepB, voffB); PG8_STAGE(PG8_SA(1, 0), cA + kstepA, voffA); PG8_STAGE(PG8_SB(1, 1), cB + hstepB + kstepB, voffB);
        PG8_WAIT_V(6); PG8_BAR;
    }
    for (;;) {
        const bool has_next = S.next(ui + 1, nxt);
        const char* nA = has_next ? (const char*)g.A + (size_t)nxt.pm * tstepA + (size_t)(nxt.pm >> 3) * g.a_bextra : cA; const char* nB = has_next ? (const char*)g.Bt + (size_t)nxt.pn * tstepB : cB;
        for (int t = 0; t < nt; t += 2) {
            const bool last = (t == nt - 2);
            const char* a1 = cA + (size_t)(t + 1) * kstepA;
            const char* a2 = last ? nA : cA + (size_t)(t + 2) * kstepA; const char* b2 = last ? nB : cB + (size_t)(t + 2) * kstepB;
            const char* a3 = a2 + kstepA; const char* b3 = b2 + kstepB;
            if (last && has_next) S.a_ready(nxt);
            if constexpr (Epi::MID_T > 0) { if (t == Epi::MID_T) { Unit mu = cur; unsigned mo_ = ~0u; asm volatile("" : "+s"(mo_)); const int ml_ = (int)__builtin_amdgcn_mbcnt_hi(mo_, __builtin_amdgcn_mbcnt_lo(mo_, 0u)); int mfr = ml_ & 15, mfq = ml_ >> 4; asm volatile("" : "+s"(mu.pm), "+s"(mu.pn), "+v"(mfr), "+v"(mfq)); E.mid(acc, mu, wr, wc, mfr, mfq); } }
            if constexpr (SP2) {
            PG8_LDB(B0, 0, 0); PG8_LDB(B1, 0, 1); PG8_SCHED; PG8_LDA(At, 0, 0); PG8_STAGE(PG8_SA(1, 1), a1 + hstepA, voffA);
            PG8_WAIT_V(8); PG8_WAIT_L(0); PG8_BAR; PG8_MMA(0, 0, At, B0); PG8_MMA(0, 1, At, B1); PG8_BAR; PG8_SCHED;
            PG8_LDA(At, 0, 1); PG8_STAGE(PG8_SB(0, 0), b2, voffB); PG8_STAGE(PG8_SB(0, 1), b2 + hstepB, voffB); PG8_STAGE(PG8_SA(0, 0), a2, voffA);
            PG8_WAIT_V(8); PG8_WAIT_L(0); PG8_BAR; PG8_MMA(1, 0, At, B0); PG8_MMA(1, 1, At, B1); PG8_BAR; PG8_SCHED;
            PG8_LDB(B0, 1, 0); PG8_LDB(B1, 1, 1); PG8_SCHED; PG8_LDA(At, 1, 0); PG8_STAGE(PG8_SA(0, 1), a2 + hstepA, voffA);
            PG8_WAIT_V(8); PG8_WAIT_L(0); PG8_BAR; PG8_MMA(0, 0, At, B0); PG8_MMA(0, 1, At, B1); PG8_BAR; PG8_SCHED;
            PG8_LDA(At, 1, 1); PG8_STAGE(PG8_SB(1, 0), b3, voffB); PG8_STAGE(PG8_SB(1, 1), b3 + hstepB, voffB); PG8_STAGE(PG8_SA(1, 0), a3, voffA);
            PG8_WAIT_V(8); PG8_WAIT_L(0); PG8_BAR; PG8_MMA(1, 0, At, B0); PG8_MMA(1, 1, At, B1); PG8_BAR; PG8_SCHED;
            } else {
            PG8_LDB(B0, 0, 0); PG8_SCHED; PG8_LDA(At, 0, 0); PG8_STAGE(PG8_SA(1, 1), a1 + hstepA, voffA);
            PG8_WAIT_L(8); PG8_BAR; PG8_WAIT_L(0); PG8_MMA(0, 0, At, B0); PG8_BAR; PG8_SCHED;
            PG8_LDB(B1, 0, 1); PG8_STAGE(PG8_SB(0, 0), b2, voffB);
            PG8_BAR; PG8_WAIT_L(0); PG8_MMA(0, 1, At, B1); PG8_BAR;
            PG8_LDA(At, 0, 1); PG8_STAGE(PG8_SA(0, 0), a2, voffA);
            PG8_BAR; PG8_WAIT_L(0); PG8_MMA(1, 0, At, B0); PG8_BAR; PG8_SCHED;
            PG8_STAGE(PG8_SB(0, 1), b2 + hstepB, voffB);
            PG8_WAIT_V(6); PG8_BAR; PG8_MMA(1, 1, At, B1); PG8_BAR;
            PG8_LDB(B0, 1, 0); PG8_SCHED; PG8_LDA(At, 1, 0); PG8_STAGE(PG8_SA(0, 1), a2 + hstepA, voffA);
            PG8_WAIT_L(8); PG8_BAR; PG8_WAIT_L(0); PG8_MMA(0, 0, At, B0); PG8_BAR; PG8_SCHED;
            PG8_LDB(B1, 1, 1); PG8_STAGE(PG8_SB(1, 0), b3, voffB);
            PG8_BAR; PG8_WAIT_L(0); PG8_MMA(0, 1, At, B1); PG8_BAR;
            PG8_LDA(At, 1, 1); PG8_STAGE(PG8_SA(1, 0), a3, voffA);
            PG8_BAR; PG8_WAIT_L(0); PG8_MMA(1, 0, At, B0); PG8_BAR; PG8_SCHED;
            PG8_STAGE(PG8_SB(1, 1), b3 + hstepB, voffB);
            PG8_WAIT_V(6); PG8_BAR; PG8_MMA(1, 1, At, B1); PG8_BAR;
            }
        }
        if constexpr (ALIGN_EPI) { if (wr == 0) PG8_BAR; }
        if constexpr (!Epi::AFTER_DRAIN) { Unit eu = cur; unsigned eo_ = ~0u; asm volatile("" : "+s"(eo_)); const int el_ = (int)__builtin_amdgcn_mbcnt_hi(eo_, __builtin_amdgcn_mbcnt_lo(eo_, 0u)); int efr = el_ & 15, efq = el_ >> 4; asm volatile("" : "+s"(eu.pm), "+s"(eu.pn), "+v"(efr), "+v"(efq));
            E(acc, eu, wr, wc, efr, efq); S.done(cur); }
        if (!has_next) break;
#pragma unroll
        for (int a = 0; a < 2; ++a)
#pragma unroll
            for (int b = 0; b < 2; ++b)
#pragma unroll
                for (int m = 0; m < 4; ++m)
#pragma unroll
                    for (int n = 0; n < 2; ++n) acc[a][b][m][n] = (f32x4){0.f, 0.f, 0.f, 0.f};
        cur = nxt; cA = nA; cB = nB; ++ui;
        if constexpr (ALIGN_EPI) { if (wr == 1) PG8_BAR; }
    }
    PG8_WAIT_V(0);
    if constexpr (!ALIGN_EPI) { if (wr == 0) PG8_BAR; }
    PG8_BAR;
    if constexpr (Epi::AFTER_DRAIN) { E.fused(acc, cur, wr, wc, fr, fq, lds, wid, lane); S.done(cur); }
#undef PG8_SA
#undef PG8_SB
#undef PG8_STAGE
#undef PG8_LDA
#undef PG8_LDB
#undef PG8_MMA
#undef PG8_WAIT_V
#undef PG8_WAIT_L
#undef PG8_BAR
#undef PG8_SCHED
}
}

constexpr int BATCH = 16, SEQ = 2048, DM = 1024, MROWS = BATCH * SEQ, DEPTH = 4;
constexpr int INW = 4888, NPAD = 5120, DFF = 4096, NCOND = 6 * DM;
constexpr int NCMP = 127;
constexpr float EPS = 1e-6f;
constexpr int XRP = 2048;
constexpr float C2 = 0.125f * 1.4426950408889634f;
#define GAS __attribute__((address_space(1)))
#define LAS __attribute__((address_space(3)))
typedef unsigned short bf16;
typedef unsigned v4u __attribute__((ext_vector_type(4)));
typedef unsigned v2u __attribute__((ext_vector_type(2)));
typedef float f32x4 __attribute__((ext_vector_type(4)));
__device__ __forceinline__ float bf_lo(unsigned u) { return __uint_as_float(u << 16); }
__device__ __forceinline__ float bf_hi(unsigned u) { return __uint_as_float(u & 0xffff0000u); }
__device__ __forceinline__ float bf2f(bf16 h) { return __uint_as_float(((unsigned)h) << 16); }
__device__ __forceinline__ unsigned pk2(float lo, float hi) { return pg8::cvt_pk_bf16(lo, hi); }
__device__ __forceinline__ float fast_exp2(float x) { return __builtin_amdgcn_exp2f(x); }
__device__ __forceinline__ float sigmoidf_(float x) { return __builtin_amdgcn_rcpf(1.0f + fast_exp2(-1.4426950408889634f * x)); }

constexpr size_t KiB = 1024, MiB = 1u << 20;
constexpr size_t WS_CTL = 0, CTL_ZERO_BYTES = 64 * KiB;
constexpr size_t WS_COND = 64 * KiB;
constexpr size_t WS_BINP = WS_COND + (size_t)DEPTH * BATCH * NCOND * 4;
constexpr size_t WS_ROPEC = WS_BINP + (size_t)DEPTH * NPAD * 4;
constexpr size_t WS_ROPES = WS_ROPEC + (size_t)MROWS * 32 * 4;
constexpr size_t WS_NG = WS_ROPES + (size_t)MROWS * 32 * 4;
constexpr size_t WS_KCMP = WS_NG + (size_t)MROWS * 24 * 4;
constexpr size_t WS_VCMP = WS_KCMP + (size_t)BATCH * 2 * 128 * 64 * 2;
constexpr size_t WS_W = WS_VCMP + (size_t)BATCH * 2 * 128 * 64 * 2;
constexpr size_t W_IN = 0, W_UP = W_IN + (size_t)NPAD * DM * 2, W_O = W_UP + (size_t)DM * DM * 2, W_F1 = W_O + (size_t)DM * DM * 2, W_F2 = W_F1 + (size_t)DFF * DM * 2, W_LAYER = W_F2 + (size_t)DM * DFF * 2;
constexpr size_t WS_CW = WS_W + DEPTH * W_LAYER;
constexpr size_t CW_W1T = 0, CW_W2T = 8 * MiB, CW_B1 = CW_W2T + 256 * KiB;
constexpr size_t WS_A1 = WS_CW + 9 * MiB;
constexpr size_t ARENA_B = 16 * MiB;
constexpr size_t WS_MG = WS_A1, WS_ZC = WS_A1 + 8 * MiB, WS_U = WS_ZC, WS_Q = WS_A1 + 14 * MiB;
constexpr size_t XE_MG = (ARENA_B - (size_t)SEQ * 2048 * 2) / 2, XE_ZC = (ARENA_B - (size_t)SEQ * 1536 * 2) / 2, XE_U = (ARENA_B - (size_t)SEQ * 1024 * 2) / 2, XE_Q = (ARENA_B - (size_t)SEQ * 512 * 2) / 2;
constexpr size_t WS_KV = WS_A1 + 256 * MiB;
constexpr size_t WS_CVAO = WS_KV + 48 * MiB, WS_H = WS_CVAO;
constexpr size_t WS_END = WS_CVAO + 64 * MiB;
static_assert(WS_END <= 512 * MiB, "workspace map exceeds 512 MiB");
static_assert(WS_ROPEC % 256 == 0 && WS_W % 256 == 0 && WS_A1 % 256 == 0, "alignment");
constexpr int CW_BAR = 1024;

namespace pg8 {
typedef unsigned u32x2 __attribute__((ext_vector_type(2)));
struct EpiIn {
    static constexpr bool PERM = true, AFTER_DRAIN = false; static constexpr int MID_T = 0;
    GAS unsigned char* ws; const GAS float* bias;
    __device__ __forceinline__ void operator()(const f32x4 (&acc)[2][2][4][2], const Unit& u, int wr, int wc, int fr, int fq) const {
        const size_t bt = (size_t)(u.pm >> 3);
        GAS bf16_t* ZC = (GAS bf16_t*)(ws + WS_ZC) + bt * XE_ZC; GAS bf16_t* Q = (GAS bf16_t*)(ws + WS_Q) + bt * XE_Q; GAS bf16_t* KV = (GAS bf16_t*)(ws + WS_KV); GAS bf16_t* MG = (GAS bf16_t*)(ws + WS_MG) + bt * XE_MG; GAS float* NG = (GAS float*)(ws + WS_NG);
        const GAS float* RC = (const GAS float*)(ws + WS_ROPEC); const GAS float* RS = (const GAS float*)(ws + WS_ROPES);
        const int row0 = u.pm * BM + wr * 64 + fr;
        const int pc0 = u.pn * BM + wc * 32 + 8 * fq;
        f32x4 bv[2][2];
#pragma unroll
        for (int bj = 0; bj < 2; ++bj)
#pragma unroll
            for (int n = 0; n < 2; ++n) bv[bj][n] = *(const GAS f32x4*)(bias + pc0 + bj * HALF + 4 * n);
        const int pn = u.pn;
        if (pn < 6) {
#pragma unroll
            for (int ai = 0; ai < 2; ++ai)
#pragma unroll
                for (int m = 0; m < 4; ++m) { GAS bf16_t* rowp = ZC + (size_t)(row0 + ai * HALF + m * 16) * 1536 + pc0;
#pragma unroll
                    for (int bj = 0; bj < 2; ++bj) { const f32x4 v0 = acc[ai][bj][m][0] + bv[bj][0], v1 = acc[ai][bj][m][1] + bv[bj][1];
                        u32x4 w; w.x = cvt_pk_bf16(v0[0], v0[1]); w.y = cvt_pk_bf16(v0[2], v0[3]); w.z = cvt_pk_bf16(v1[0], v1[1]); w.w = cvt_pk_bf16(v1[2], v1[3]);
                        *(GAS u32x4*)(rowp + bj * HALF) = w; } }
        } else if (pn < 11) {
#pragma unroll
            for (int ai = 0; ai < 2; ++ai)
#pragma unroll
                for (int m = 0; m < 4; ++m) { const int row = row0 + ai * HALF + m * 16;
                    if (pn < 8 || wc < 2) {
                        const f32x4 c0 = *(const GAS f32x4*)(RC + (size_t)row * 32 + 8 * fq), c1 = *(const GAS f32x4*)(RC + (size_t)row * 32 + 8 * fq + 4);
                        const f32x4 s0 = *(const GAS f32x4*)(RS + (size_t)row * 32 + 8 * fq), s1 = *(const GAS f32x4*)(RS + (size_t)row * 32 + 8 * fq + 4);
                        const f32x4 xa0 = acc[ai][0][m][0] + bv[0][0], xa1 = acc[ai][0][m][1] + bv[0][1], xb0 = acc[ai][1][m][0] + bv[1][0], xb1 = acc[ai][1][m][1] + bv[1][1];
                        const float sc = (pn < 8) ? 0.18033688011112042f : 1.0f;
                        const f32x4 o10 = (xa0 * c0 - xb0 * s0) * sc, o11 = (xa1 * c1 - xb1 * s1) * sc, o20 = (xb0 * c0 + xa0 * s0) * sc, o21 = (xb1 * c1 + xa1 * s1) * sc;
                        GAS bf16_t* d = (pn < 8) ? Q + (size_t)row * 512 + (4 * (pn - 6) + wc) * 64 + 8 * fq : KV + (size_t)row * 768 + (pn - 8) * 256 + wc * 64 + 8 * fq;
                        u32x4 a, b; a.x = cvt_pk_bf16(o10[0], o10[1]); a.y = cvt_pk_bf16(o10[2], o10[3]); a.z = cvt_pk_bf16(o11[0], o11[1]); a.w = cvt_pk_bf16(o11[2], o11[3]);
                        b.x = cvt_pk_bf16(o20[0], o20[1]); b.y = cvt_pk_bf16(o20[2], o20[3]); b.z = cvt_pk_bf16(o21[0], o21[1]); b.w = cvt_pk_bf16(o21[2], o21[3]);
                        *(GAS u32x4*)d = a; *(GAS u32x4*)(d + 32) = b;
                    } else {
#pragma unroll
                        for (int bj = 0; bj < 2; ++bj) { const f32x4 x1 = acc[ai][bj][m][0] + bv[bj][0], x2 = acc[ai][bj][m][1] + bv[bj][1];
                            GAS bf16_t* d = KV + (size_t)row * 768 + (pn - 8) * 256 + 128 + bj * 64 + (wc - 2) * 32 + 8 * fq;
                            u32x4 w; w.x = cvt_pk_bf16(x1[0], x1[1]); w.y = cvt_pk_bf16(x1[2], x1[3]); w.z = cvt_pk_bf16(x2[0], x2[1]); w.w = cvt_pk_bf16(x2[2], x2[3]);
                            *(GAS u32x4*)d = w; }
                    } }
        } else if (pn == 11) {
            if (wc == 0 && fq < 3) {
#pragma unroll
                for (int ai = 0; ai < 2; ++ai)
#pragma unroll
                    for (int m = 0; m < 4; ++m) { GAS float* d = NG + (size_t)(row0 + ai * HALF + m * 16) * 24 + 8 * fq;
                        *(GAS f32x4*)d = acc[ai][0][m][0] + bv[0][0]; *(GAS f32x4*)(d + 4) = acc[ai][0][m][1] + bv[0][1]; }
            }
        } else {
#pragma unroll
            for (int ai = 0; ai < 2; ++ai)
#pragma unroll
                for (int m = 0; m < 4; ++m) { GAS bf16_t* rowp = MG + (size_t)(row0 + ai * HALF + m * 16) * 2048 + (pn - 12) * 128 + wc * 32 + 8 * fq;
                    f32x4 c0 = acc[ai][0][m][0] + bv[0][0], c1 = acc[ai][0][m][1] + bv[0][1], a0 = acc[ai][1][m][0] + bv[1][0], a1 = acc[ai][1][m][1] + bv[1][1];
#pragma unroll
                    for (int j = 0; j < 4; ++j) { a0[j] = fmaxf(sigmoidf_(a0[j]), 9.5367431640625e-07f); a1[j] = fmaxf(sigmoidf_(a1[j]), 9.5367431640625e-07f);
                        c0[j] = sigmoidf_(c0[j]) * __builtin_amdgcn_rcpf(a0[j]); c1[j] = sigmoidf_(c1[j]) * __builtin_amdgcn_rcpf(a1[j]); }
                    u32x4 wr_, wa_; wr_.x = cvt_pk_bf16(c0[0], c0[1]); wr_.y = cvt_pk_bf16(c0[2], c0[3]); wr_.z = cvt_pk_bf16(c1[0], c1[1]); wr_.w = cvt_pk_bf16(c1[2], c1[3]);
                    wa_.x = cvt_pk_bf16(a0[0], a0[1]); wa_.y = cvt_pk_bf16(a0[2], a0[3]); wa_.z = cvt_pk_bf16(a1[0], a1[1]); wa_.w = cvt_pk_bf16(a1[2], a1[3]);
                    *(GAS u32x4*)rowp = wr_; *(GAS u32x4*)(rowp + 1024) = wa_; }
        }
    }
};
template <int PASS> struct EpiUp {
    static constexpr bool PERM = true, AFTER_DRAIN = false; static constexpr int MID_T = 0;
    GAS bf16_t* U; const GAS bf16_t* MG;
    __device__ __forceinline__ void operator()(const f32x4 (&acc)[2][2][4][2], const Unit& u, int wr, int wc, int fr, int fq) const {
        const int row0 = u.pm * BM + wr * 64 + fr, col0 = u.pn * BM + wc * 32 + 8 * fq;
#pragma unroll
        for (int ai = 0; ai < 2; ++ai)
#pragma unroll
            for (int mh = 0; mh < 2; ++mh) {
                u32x4 gt[2][2], pv[2][2];
#pragma unroll
                for (int m2 = 0; m2 < 2; ++m2) { const size_t row = (size_t)(row0 + ai * HALF + (2 * mh + m2) * 16);
#pragma unroll
                    for (int bj = 0; bj < 2; ++bj) { gt[m2][bj] = *(const GAS u32x4*)(MG + row * 2048 + PASS * 1024 + col0 + bj * HALF);
                        if (PASS == 1) pv[m2][bj] = *(const GAS u32x4*)(U + row * 1024 + col0 + bj * HALF); } }
                asm volatile("" ::: "memory");
#pragma unroll
                for (int m2 = 0; m2 < 2; ++m2) { const size_t row = (size_t)(row0 + ai * HALF + (2 * mh + m2) * 16);
#pragma unroll
                    for (int bj = 0; bj < 2; ++bj) { const u32x4 g = gt[m2][bj];
                        f32x4 v0 = acc[ai][bj][2 * mh + m2][0], v1 = acc[ai][bj][2 * mh + m2][1];
                        v0[0] *= bf_lo(g.x); v0[1] *= bf_hi(g.x); v0[2] *= bf_lo(g.y); v0[3] *= bf_hi(g.y);
                        v1[0] *= bf_lo(g.z); v1[1] *= bf_hi(g.z); v1[2] *= bf_lo(g.w); v1[3] *= bf_hi(g.w);
                        if (PASS == 1) { const u32x4 p = pv[m2][bj];
                            v0[0] += bf_lo(p.x); v0[1] += bf_hi(p.x); v0[2] += bf_lo(p.y); v0[3] += bf_hi(p.y);
                            v1[0] += bf_lo(p.z); v1[1] += bf_hi(p.z); v1[2] += bf_lo(p.w); v1[3] += bf_hi(p.w); }
                        u32x4 w; w.x = cvt_pk_bf16(v0[0], v0[1]); w.y = cvt_pk_bf16(v0[2], v0[3]); w.z = cvt_pk_bf16(v1[0], v1[1]); w.w = cvt_pk_bf16(v1[2], v1[3]);
                        *(GAS u32x4*)(U + row * 1024 + col0 + bj * HALF) = w; } }
                asm volatile("" ::: "memory");
            }
    }
};
struct EpiUpM {
    static constexpr bool PERM = true, AFTER_DRAIN = false; static constexpr int MID_T = 8;
    GAS bf16_t* U0; const GAS bf16_t* MG0;
    __device__ __forceinline__ void mid(f32x4 (&acc)[2][2][4][2], const Unit& u, int wr, int wc, int fr, int fq) const {
        const GAS bf16_t* MG = MG0 + (size_t)(u.pm >> 3) * XE_MG;
        const int row0 = u.pm * BM + wr * 64 + fr, col0 = u.pn * BM + wc * 32 + 8 * fq;
#pragma unroll
        for (int ai = 0; ai < 2; ++ai) {
            u32x4 gr[4][2];
#pragma unroll
            for (int m = 0; m < 4; ++m)
#pragma unroll
                for (int bj = 0; bj < 2; ++bj) gr[m][bj] = *(const GAS u32x4*)(MG + (size_t)(row0 + ai * HALF + m * 16) * 2048 + col0 + bj * HALF);
#pragma unroll
            for (int m = 0; m < 4; ++m)
#pragma unroll
                for (int bj = 0; bj < 2; ++bj) { const u32x4 c = gr[m][bj];
                    f32x4& v0 = acc[ai][bj][m][0]; f32x4& v1 = acc[ai][bj][m][1];
                    v0[0] *= bf_lo(c.x); v0[1] *= bf_hi(c.x); v0[2] *= bf_lo(c.y); v0[3] *= bf_hi(c.y);
                    v1[0] *= bf_lo(c.z); v1[1] *= bf_hi(c.z); v1[2] *= bf_lo(c.w); v1[3] *= bf_hi(c.w); }
        }
    }
    __device__ __forceinline__ void operator()(const f32x4 (&acc)[2][2][4][2], const Unit& u, int wr, int wc, int fr, int fq) const {
        const GAS bf16_t* MG = MG0 + (size_t)(u.pm >> 3) * XE_MG; GAS bf16_t* U = U0 + (size_t)(u.pm >> 3) * XE_U;
        const int row0 = u.pm * BM + wr * 64 + fr, col0 = u.pn * BM + wc * 32 + 8 * fq;
#pragma unroll
        for (int ai = 0; ai < 2; ++ai) {
            u32x4 ga[4][2];
#pragma unroll
            for (int m = 0; m < 4; ++m)
#pragma unroll
                for (int bj = 0; bj < 2; ++bj) ga[m][bj] = *(const GAS u32x4*)(MG + (size_t)(row0 + ai * HALF + m * 16) * 2048 + 1024 + col0 + bj * HALF);
#pragma unroll
            for (int m = 0; m < 4; ++m) { const size_t row = (size_t)(row0 + ai * HALF + m * 16);
#pragma unroll
                for (int bj = 0; bj < 2; ++bj) { const u32x4 a = ga[m][bj];
                    f32x4 v0 = acc[ai][bj][m][0], v1 = acc[ai][bj][m][1];
                    v0[0] *= bf_lo(a.x); v0[1] *= bf_hi(a.x); v0[2] *= bf_lo(a.y); v0[3] *= bf_hi(a.y);
                    v1[0] *= bf_lo(a.z); v1[1] *= bf_hi(a.z); v1[2] *= bf_lo(a.w); v1[3] *= bf_hi(a.w);
                    u32x4 w; w.x = cvt_pk_bf16(v0[0], v0[1]); w.y = cvt_pk_bf16(v0[2], v0[3]); w.z = cvt_pk_bf16(v1[0], v1[1]); w.w = cvt_pk_bf16(v1[2], v1[3]);
                    *(GAS u32x4*)(U + row * 1024 + col0 + bj * HALF) = w; } }
        }
    }
};
struct EpiRes {
    static constexpr bool PERM = true, AFTER_DRAIN = false; static constexpr int MID_T = 0;
    const GAS float* base32; GAS bf16_t* XR; const GAS float* gate;
    __device__ __forceinline__ void operator()(const f32x4 (&acc)[2][2][4][2], const Unit& u, int wr, int wc, int fr, int fq) const {
        const int row0 = u.pm * BM + wr * 64 + fr, col0 = u.pn * BM + wc * 32 + 8 * fq;
        const GAS float* gp = gate + (size_t)(u.pm >> 3) * 6144 + col0;
        f32x4 gv[2][2];
#pragma unroll
        for (int bj = 0; bj < 2; ++bj)
#pragma unroll
            for (int n = 0; n < 2; ++n) gv[bj][n] = *(const GAS f32x4*)(gp + bj * HALF + n * 4);
        if (base32) {
#pragma unroll
            for (int ai = 0; ai < 2; ++ai)
#pragma unroll
                for (int m = 0; m < 4; ++m) { const size_t row = (size_t)(row0 + ai * HALF + m * 16);
#pragma unroll
                    for (int bj = 0; bj < 2; ++bj) { const f32x4 b0 = *(const GAS f32x4*)(base32 + row * 1024 + col0 + bj * HALF), b1 = *(const GAS f32x4*)(base32 + row * 1024 + col0 + bj * HALF + 4);
                        const f32x4 o0 = b0 + gv[bj][0] * acc[ai][bj][m][0], o1 = b1 + gv[bj][1] * acc[ai][bj][m][1];
                        u32x4 w; w.x = cvt_pk_bf16(o0[0], o0[1]); w.y = cvt_pk_bf16(o0[2], o0[3]); w.z = cvt_pk_bf16(o1[0], o1[1]); w.w = cvt_pk_bf16(o1[2], o1[3]);
                        *(GAS u32x4*)(XR + row * XRP + col0 + bj * HALF) = w; } }
        } else {
#pragma unroll
            for (int ai = 0; ai < 2; ++ai) {
                u32x4 bs[4][2];
#pragma unroll
                for (int m = 0; m < 4; ++m)
#pragma unroll
                    for (int bj = 0; bj < 2; ++bj) bs[m][bj] = *(const GAS u32x4*)(XR + (size_t)(row0 + ai * HALF + m * 16) * XRP + col0 + bj * HALF);
                asm volatile("" ::: "memory");
#pragma unroll
                for (int m = 0; m < 4; ++m)
#pragma unroll
                    for (int bj = 0; bj < 2; ++bj) { const u32x4 b = bs[m][bj];
                        const f32x4 b0 = (f32x4){bf_lo(b.x), bf_hi(b.x), bf_lo(b.y), bf_hi(b.y)}, b1 = (f32x4){bf_lo(b.z), bf_hi(b.z), bf_lo(b.w), bf_hi(b.w)};
                        const f32x4 o0 = b0 + gv[bj][0] * acc[ai][bj][m][0], o1 = b1 + gv[bj][1] * acc[ai][bj][m][1];
                        u32x4 w; w.x = cvt_pk_bf16(o0[0], o0[1]); w.y = cvt_pk_bf16(o0[2], o0[3]); w.z = cvt_pk_bf16(o1[0], o1[1]); w.w = cvt_pk_bf16(o1[2], o1[3]);
                        *(GAS u32x4*)(XR + (size_t)(row0 + ai * HALF + m * 16) * XRP + col0 + bj * HALF) = w; }
                asm volatile("" ::: "memory");
            }
        }
    }
};
struct EpiFf1 {
    static constexpr bool PERM = true, AFTER_DRAIN = false; static constexpr int MID_T = 0;
    GAS bf16_t* O;
    __device__ __forceinline__ void operator()(const f32x4 (&acc)[2][2][4][2], const Unit& u, int wr, int wc, int fr, int fq) const {
        const int row0 = u.pm * BM + wr * 64 + fr, col0 = u.pn * BM + wc * 32 + 8 * fq;
#pragma unroll
        for (int ai = 0; ai < 2; ++ai)
#pragma unroll
            for (int m = 0; m < 4; ++m) { GAS bf16_t* rowp = O + (size_t)(row0 + ai * HALF + m * 16) * 4096 + col0;
#pragma unroll
                for (int bj = 0; bj < 2; ++bj) { f32x4 v0 = acc[ai][bj][m][0], v1 = acc[ai][bj][m][1];
#pragma unroll
                    for (int j = 0; j < 4; ++j) { const float a = fmaxf(v0[j], 0.f), b = fmaxf(v1[j], 0.f); v0[j] = a * a; v1[j] = b * b; }
                    u32x4 w; w.x = cvt_pk_bf16(v0[0], v0[1]); w.y = cvt_pk_bf16(v0[2], v0[3]); w.z = cvt_pk_bf16(v1[0], v1[1]); w.w = cvt_pk_bf16(v1[2], v1[3]);
                    *(GAS u32x4*)(rowp + bj * HALF) = w; } }
    }
};

struct OneUnit {
    bool active; int pm;
    __device__ __forceinline__ bool next(int i, Unit& u) const { if (i == 0 && active) { u.pm = pm; u.pn = 0; return true; } return false; }
    __device__ __forceinline__ void a_ready(const Unit&) const {}
    __device__ __forceinline__ void done(const Unit&) const {}
};
struct OneUnitSig {
    bool active; int pm; GAS unsigned* flag;
    __device__ __forceinline__ bool next(int i, Unit& u) const { if (i == 0 && active) { u.pm = pm; u.pn = 0; return true; } return false; }
    __device__ __forceinline__ void a_ready(const Unit&) const {}
    __device__ __forceinline__ void done(const Unit&) const {
        asm volatile("s_waitcnt vmcnt(0)" ::: "memory");
        if (__builtin_amdgcn_mbcnt_hi(~0u, __builtin_amdgcn_mbcnt_lo(~0u, 0u)) == 0u) (void)__hip_atomic_fetch_add(flag, 1u, __ATOMIC_RELAXED, __HIP_MEMORY_SCOPE_AGENT);
    }
};
struct EpiCmpPart {
    static constexpr bool PERM = true, AFTER_DRAIN = false; static constexpr int MID_T = 0;
    GAS unsigned char* part;
    __device__ __forceinline__ void operator()(const f32x4 (&acc)[2][2][4][2], const Unit& u, int wr, int wc, int fr, int fq) const {
        const int col0 = wc * 32 + 8 * fq;
#pragma unroll
        for (int ai = 0; ai < 2; ++ai)
#pragma unroll
            for (int m = 0; m < 4; ++m) { GAS unsigned char* rowp = part + (size_t)(ai * HALF + wr * 64 + m * 16 + fr) * 4096 + col0 * 2;
#pragma unroll
                for (int bj = 0; bj < 2; ++bj) { const f32x4 v0 = acc[ai][bj][m][0], v1 = acc[ai][bj][m][1];
                    u32x4 w; w.x = cvt_pk_bf16(v0[0], v0[1]); w.y = cvt_pk_bf16(v0[2], v0[3]); w.z = cvt_pk_bf16(v1[0], v1[1]); w.w = cvt_pk_bf16(v1[2], v1[3]);
                    *(GAS u32x4*)(rowp + bj * HALF * 2) = w; } }
    }
};
struct EpiCmp {
    static constexpr bool PERM = true, AFTER_DRAIN = true; static constexpr int MID_T = 0;
    const GAS float* bias1; const GAS bf16_t* W2T; GAS bf16_t* OUT; const GAS unsigned char* part; GAS unsigned* flag;
    __device__ __forceinline__ void fused(f32x4 (&acc)[2][2][4][2], const Unit& u, int wr, int wc, int fr, int fq, PG8_LAS unsigned char* lds, int wid, int lane) const {
        const int col0 = wc * 32 + 8 * fq;
        if (wid == 0 && lane == 0) { unsigned sp = 0u;
            while (__hip_atomic_load(flag, __ATOMIC_RELAXED, __HIP_MEMORY_SCOPE_AGENT) < 8u) { __builtin_amdgcn_s_sleep(1); if (++sp > (1u << 22)) break; }
            __builtin_amdgcn_fence(__ATOMIC_ACQUIRE, "agent"); asm volatile("s_waitcnt vmcnt(0)" ::: "memory"); }
        asm volatile("s_waitcnt lgkmcnt(0)" ::: "memory"); __builtin_amdgcn_s_barrier(); asm volatile("" ::: "memory");
#pragma unroll
        for (int ai = 0; ai < 2; ++ai) {
            u32x4 pp[4][2];
#pragma unroll
            for (int m = 0; m < 4; ++m)
#pragma unroll
                for (int bj = 0; bj < 2; ++bj) pp[m][bj] = *(const GAS u32x4*)(part + (size_t)(ai * HALF + wr * 64 + m * 16 + fr) * 4096 + (col0 + bj * HALF) * 2);
#pragma unroll
            for (int m = 0; m < 4; ++m)
#pragma unroll
                for (int bj = 0; bj < 2; ++bj) { const u32x4 p = pp[m][bj];
                    acc[ai][bj][m][0] += (f32x4){bf_lo(p.x), bf_hi(p.x), bf_lo(p.y), bf_hi(p.y)}; acc[ai][bj][m][1] += (f32x4){bf_lo(p.z), bf_hi(p.z), bf_lo(p.w), bf_hi(p.w)}; }
        }
        f32x4 bv[2][2];
#pragma unroll
        for (int bj = 0; bj < 2; ++bj)
#pragma unroll
            for (int n = 0; n < 2; ++n) { f32x4 s = *(const GAS f32x4*)(bias1 + col0 + bj * HALF + 4 * n);
#pragma unroll
                for (int p = 1; p < 8; ++p) s += *(const GAS f32x4*)(bias1 + p * 256 + col0 + bj * HALF + 4 * n);
                bv[bj][n] = s; }
#pragma unroll
        for (int ai = 0; ai < 2; ++ai)
#pragma unroll
            for (int m = 0; m < 4; ++m) { const int row = ai * HALF + wr * 64 + m * 16 + fr;
#pragma unroll
                for (int bj = 0; bj < 2; ++bj) { f32x4 v0 = acc[ai][bj][m][0] + bv[bj][0], v1 = acc[ai][bj][m][1] + bv[bj][1];
#pragma unroll
                    for (int j = 0; j < 4; ++j) { v0[j] = v0[j] * sigmoidf_(v0[j]); v1[j] = v1[j] * sigmoidf_(v1[j]); }
                    u32x4 w; w.x = cvt_pk_bf16(v0[0], v0[1]); w.y = cvt_pk_bf16(v0[2], v0[3]); w.z = cvt_pk_bf16(v1[0], v1[1]); w.w = cvt_pk_bf16(v1[2], v1[3]);
                    const int chunk = (col0 + bj * HALF) >> 3;
                    *(PG8_LAS u32x4*)(lds + row * 512 + ((chunk ^ (row & 15)) << 4)) = w; } }
        asm volatile("s_waitcnt lgkmcnt(0)" ::: "memory"); __builtin_amdgcn_s_barrier(); asm volatile("" ::: "memory");
        const int r = lane & 15, q = lane >> 4;
        f32x4 o[2][4];
#pragma unroll
        for (int rt = 0; rt < 2; ++rt)
#pragma unroll
            for (int ct = 0; ct < 4; ++ct) o[rt][ct] = (f32x4){0.f, 0.f, 0.f, 0.f};
#pragma unroll
        for (int ks = 0; ks < 8; ++ks) {
            bf16x8 bfr[4], afr[2];
#pragma unroll
            for (int ct = 0; ct < 4; ++ct) bfr[ct] = *(const GAS bf16x8*)(W2T + (size_t)(16 * ct + r) * 256 + 32 * ks + 8 * q);
#pragma unroll
            for (int rt = 0; rt < 2; ++rt) { const int row = 32 * wid + 16 * rt + r; afr[rt] = *(const PG8_LAS bf16x8*)(lds + row * 512 + (((4 * ks + q) ^ (row & 15)) << 4)); }
#pragma unroll
            for (int rt = 0; rt < 2; ++rt)
#pragma unroll
                for (int ct = 0; ct < 4; ++ct) o[rt][ct] = __builtin_amdgcn_mfma_f32_16x16x32_bf16(bfr[ct], afr[rt], o[rt][ct], 0, 0, 0);
        }
#pragma unroll
        for (int rt = 0; rt < 2; ++rt) { const int row = 32 * wid + 16 * rt + r; const bool pad = (row & 127) == 127;
            GAS bf16_t* d = OUT + ((size_t)u.pm * 256 + row) * 64 + 4 * q;
#pragma unroll
            for (int ct = 0; ct < 4; ++ct) { u32x2 w; w.x = pad ? 0u : cvt_pk_bf16(o[rt][ct][0], o[rt][ct][1]); w.y = pad ? 0u : cvt_pk_bf16(o[rt][ct][2], o[rt][ct][3]);
                *(GAS u32x2*)(d + 16 * ct) = w; } }
    }
};
}

constexpr int RING_BYTES = 131072, LDSCTL_OFF = RING_BYTES, MISC_OFF = LDSCTL_OFF + 320, LDS_BYTES = 147456;
constexpr int NWAVES = 8;

#define XB_TMO      128
#define XB_XCNT(j)  (256  + 64 * (j))
#define XB_XSUB(j)  (1280 + 64 * (j))
#define XB_XGEN(j)  (2304 + 64 * (j))
#define XB_TOP      3328
#define XB_TOPGEN   3392
#define XCD_BAR_WORDS 3456
#define XB_SPIN_CAP (1u << 18)
static_assert((CW_BAR + XCD_BAR_WORDS) * 4 <= (int)CTL_ZERO_BYTES, "barrier words inside the memset region");
__device__ __forceinline__ unsigned xb_ld(GAS unsigned* p)              { return __hip_atomic_load(p, __ATOMIC_RELAXED, __HIP_MEMORY_SCOPE_AGENT); }
__device__ __forceinline__ unsigned xb_add(GAS unsigned* p, unsigned v) { return __hip_atomic_fetch_add(p, v, __ATOMIC_RELAXED, __HIP_MEMORY_SCOPE_AGENT); }
__device__ __forceinline__ unsigned xb_xcc_id() { return (unsigned)__builtin_amdgcn_s_getreg((3 << 11) | 20) & 0xFu; }
#define XB_SPIN(cond, bar) do { unsigned _sp = 0; while (cond) { __builtin_amdgcn_s_sleep(1); \
    if ((++_sp & 255u) == 0u) { if (xb_ld(&(bar)[XB_TMO])) break; if (_sp > XB_SPIN_CAP) { atomicAdd((unsigned*)&(bar)[XB_TMO], 1u); break; } } } } while (0)
struct XcdBarrier { GAS unsigned* bar; unsigned x; volatile LAS unsigned* st; };
__device__ __forceinline__ XcdBarrier xcd_barrier_post(GAS unsigned* bar, volatile LAS unsigned* st, int tid) {
    XcdBarrier b; b.bar = bar; b.x = xb_xcc_id(); b.st = st;
    if (tid == 0) st[2] = xb_add(&bar[XB_XCNT(b.x)], 1u);
    return b;
}
__device__ __forceinline__ void xcd_barrier_complete(GAS unsigned* bar, unsigned x, unsigned& nloc, unsigned& nx, unsigned& didx) {
    const unsigned G = gridDim.x * gridDim.y * gridDim.z;
    unsigned sum, cnt, mine, sp = 0u;
    for (;;) {
        sum = 0u; cnt = 0u; mine = 0u; didx = 0u;
#pragma unroll 1
        for (unsigned j = 0; j < 16; ++j) { const unsigned c = xb_ld(&bar[XB_XCNT(j)]); sum += c; cnt += (c > 0u) ? 1u : 0u; mine = (j == x) ? c : mine; didx += (j < x && c > 0u) ? 1u : 0u; }
        if (sum == G) break;
        __builtin_amdgcn_s_sleep(1);
        if ((++sp & 255u) == 0u) { if (xb_ld(&bar[XB_TMO])) break; if (sp > XB_SPIN_CAP) { atomicAdd((unsigned*)&bar[XB_TMO], 1u); break; } }
    }
    nloc = mine > 0u ? mine : 1u; nx = cnt > 0u ? cnt : 1u;
}
__device__ __forceinline__ void xcd_barrier(const XcdBarrier& b, int wave) {
    asm volatile("s_waitcnt vmcnt(0)" ::: "memory");
    __syncthreads();
    if (wave == 0 && __builtin_amdgcn_mbcnt_hi(~0u, __builtin_amdgcn_mbcnt_lo(~0u, 0u)) == 0u) {
        GAS unsigned* bar = b.bar; unsigned bx = b.x;
        asm volatile("" : "+s"(bar), "+s"(bx));
        __builtin_amdgcn_s_waitcnt(0);
        unsigned nloc = b.st[0], nx = b.st[1];
        if (nloc == 0u) { unsigned didx; xcd_barrier_complete(bar, bx, nloc, nx, didx); b.st[0] = nloc; b.st[1] = nx;
            const unsigned b0 = didx * (unsigned)BATCH / nx, b1 = (didx + 1u) * (unsigned)BATCH / nx; b.st[4] = b0; b.st[5] = b1 - b0; }
        const unsigned old = xb_add(&bar[XB_XSUB(bx)], 1u);
        const unsigned gen = old / nloc;
        if (old + 1u == (gen + 1u) * nloc) {
            __builtin_amdgcn_fence(__ATOMIC_RELEASE, "agent");
            asm volatile("s_waitcnt vmcnt(0)" ::: "memory");
            const unsigned og = xb_add(&bar[XB_TOP], 1u);
            const unsigned tg = og / nx;
            if (og + 1u == (tg + 1u) * nx) xb_add(&bar[XB_TOPGEN], 1u);
            else XB_SPIN(xb_ld(&bar[XB_TOPGEN]) == tg, bar);
            __builtin_amdgcn_fence(__ATOMIC_ACQUIRE, "agent");
            xb_add(&bar[XB_XGEN(bx)], 1u);
            asm volatile("s_waitcnt vmcnt(0)" ::: "memory");
        } else {
            XB_SPIN(xb_ld(&bar[XB_XGEN(bx)]) == gen, bar);
            __builtin_amdgcn_fence(__ATOMIC_ACQUIRE, "agent");
            asm volatile("s_waitcnt vmcnt(0)" ::: "memory");
        }
    }
    __syncthreads();
}

__device__ __forceinline__ void dom_barrier(const XcdBarrier& b, int wave) {
    asm volatile("s_waitcnt vmcnt(0)" ::: "memory");
    __syncthreads();
    if (wave == 0 && __builtin_amdgcn_mbcnt_hi(~0u, __builtin_amdgcn_mbcnt_lo(~0u, 0u)) == 0u) {
        GAS unsigned* bar = b.bar; unsigned bx = b.x;
        asm volatile("" : "+s"(bar), "+s"(bx));
        __builtin_amdgcn_s_waitcnt(0);
        const unsigned nloc = b.st[0];
        const unsigned old = xb_add(&bar[XB_XSUB(bx)], 1u);
        const unsigned gen = old / nloc;
        if (old + 1u == (gen + 1u) * nloc) xb_add(&bar[XB_XGEN(bx)], 1u);
        else XB_SPIN(xb_ld(&bar[XB_XGEN(bx)]) == gen, bar);
        __builtin_amdgcn_fence(__ATOMIC_ACQUIRE, "agent");
        asm volatile("s_waitcnt vmcnt(0)" ::: "memory");
    }
    __syncthreads();
}

struct Frame {
    LAS unsigned char* lds;
    int tid, lane, wave, vcu, G;
    int rk, nl, b0, nb;
    GAS float* out; GAS unsigned char* ws;
};
constexpr int PTR_OFF = 131072 + 1024;
__device__ __forceinline__ const GAS float* INP(const Frame& F, int i) {
    unsigned a = (unsigned)(PTR_OFF + 8 * i); asm volatile("" : "+v"(a));
    const unsigned long long v = *(const LAS unsigned long long*)(F.lds + a);
    const unsigned lo = (unsigned)__builtin_amdgcn_readfirstlane((int)(unsigned)v), hi = (unsigned)__builtin_amdgcn_readfirstlane((int)(unsigned)(v >> 32));
    return (const GAS float*)(((unsigned long long)hi << 32) | lo);
}
#define LDS_WAIT() asm volatile("s_waitcnt lgkmcnt(0)" ::: "memory")
constexpr int DOM_OFF = 131072 + 320 + 32;
__device__ __forceinline__ void dom_load(Frame& F) {
    unsigned a = (unsigned)DOM_OFF; asm volatile("" : "+v"(a));
    const LAS unsigned* st = (const LAS unsigned*)(F.lds + a);
    F.nl = __builtin_amdgcn_readfirstlane((int)st[0]); F.rk = __builtin_amdgcn_readfirstlane((int)st[2]); F.b0 = __builtin_amdgcn_readfirstlane((int)st[4]); F.nb = __builtin_amdgcn_readfirstlane((int)st[5]);
}
__device__ __forceinline__ float wave_sum(float v) {
#pragma unroll
    for (int o = 1; o < 64; o <<= 1) v += __shfl_xor(v, o);
    return v;
}
__device__ __forceinline__ float wave_max(float v) {
#pragma unroll
    for (int o = 1; o < 64; o <<= 1) v = fmaxf(v, __shfl_xor(v, o));
    return v;
}
__device__ __forceinline__ float rdlane(float v, int l) { return __int_as_float(__builtin_amdgcn_readlane(__float_as_int(v), l)); }

__device__ __forceinline__ int cmap_in(int p) {
    if (p < 1536) return p;
    if (p < 2048) { const int t = (p - 1536) >> 8, q = (p - 1536) & 255, bj = q >> 7, r = q & 127; return 1536 + (4 * t + (r >> 5)) * 64 + bj * 32 + (r & 31); }
    if (p < 2816) { const int seg = (p - 2048) >> 8, q = (p - 2048) & 255, bj = q >> 7, r = q & 127;
        if (r < 64) return 2048 + seg * 256 + (r >> 5) * 64 + bj * 32 + (r & 31);
        return 2048 + seg * 256 + 128 + bj * 64 + (r - 64); }
    if (p < 3072) { const int q = p - 2816; return q < 24 ? 2816 + q : -1; }
    { const int t = (p - 3072) >> 8, q = (p - 3072) & 255, bj = q >> 7, r = q & 127; return 2840 + bj * 1024 + 128 * t + r; }
}
struct TrDesc { const GAS float* W; GAS bf16* WT; int ldw, nblk, ldt, kdst0, item; bool mapped; };
struct TrRegs { f32x4 v[8]; };
__device__ __forceinline__ void tr_load(const TrDesc& d, TrRegs& t, int lane) {
    const int kb = d.item / d.nblk, nb = d.item % d.nblk, k0 = 64 * kb, p0 = 32 * nb;
    const int kk = lane >> 3, ch = lane & 7;
    const int c = d.mapped ? cmap_in(p0 + 4 * ch) : p0 + 4 * ch;
#pragma unroll
    for (int i = 0; i < 8; ++i) { const int k = 8 * i + kk;
        t.v[i] = (c >= 0) ? *(const GAS f32x4*)(d.W + (size_t)(k0 + k) * d.ldw + c) : (f32x4){0.f, 0.f, 0.f, 0.f}; }
}
__device__ __forceinline__ void tr_finish(const TrDesc& d, const TrRegs& t, LAS float* scr, int lane) {
    const int kb = d.item / d.nblk, nb = d.item % d.nblk, k0 = 64 * kb, p0 = 32 * nb;
    const int kk = lane >> 3, ch = lane & 7;
#pragma unroll
    for (int i = 0; i < 8; ++i) { const int k = 8 * i + kk; *(LAS f32x4*)(scr + k * 36 + 4 * ch) = t.v[i]; }
    LDS_WAIT(); asm volatile("" ::: "memory");
    const int cc = lane & 7;
#pragma unroll
    for (int j = 0; j < 4; ++j) { const int n = (lane >> 3) + 8 * j; const LAS float* s = scr + (8 * cc) * 36 + n;
        v4u o; o.x = pk2(s[0 * 36], s[1 * 36]); o.y = pk2(s[2 * 36], s[3 * 36]); o.z = pk2(s[4 * 36], s[5 * 36]); o.w = pk2(s[6 * 36], s[7 * 36]);
        *(GAS v4u*)(d.WT + (size_t)(p0 + n) * d.ldt + d.kdst0 + k0 + 8 * cc) = o; }
    LDS_WAIT(); asm volatile("" ::: "memory");
}

__device__ __forceinline__ void p0_prologue(Frame& F) {
    const int gw = F.vcu * NWAVES + F.wave, NGW = F.G * NWAVES;
    const int gtid = F.vcu * 512 + F.tid, NT = F.G * 512;
    {
        LAS float* cactT = (LAS float*)F.lds;
        LAS float* red = (LAS float*)(F.lds + 65536);
        const GAS float* c = INP(F, 1);
        for (int i = F.tid; i < BATCH * DM; i += 512) { const int b = i >> 10, k = i & 1023; const float v = c[i]; cactT[k * 16 + b] = v * sigmoidf_(v); }
        __syncthreads();
        for (int unit = F.vcu; unit < DEPTH * 64; unit += F.G) {
            const int l = unit >> 6, col0 = (unit & 63) * 96;
            const GAS float* wp = INP(F, 3) + (size_t)l * DM * NCOND + col0 + F.lane;
            const GAS float* wq = INP(F, 3) + (size_t)l * DM * NCOND + col0 + 64 + (F.lane & 31);
            float acc[16], acd[16];
#pragma unroll
            for (int b = 0; b < 16; ++b) { acc[b] = 0.f; acd[b] = 0.f; }
            const int kbeg = F.wave * 128;
#pragma unroll 32
            for (int k = kbeg; k < kbeg + 128; ++k) {
                const float wv = wp[(size_t)k * NCOND], wu = wq[(size_t)k * NCOND];
                const LAS f32x4* cp = (const LAS f32x4*)(cactT + k * 16);
                const f32x4 c0 = cp[0], c1 = cp[1], c2 = cp[2], c3 = cp[3];
                acc[0] += c0[0] * wv; acc[1] += c0[1] * wv; acc[2] += c0[2] * wv; acc[3] += c0[3] * wv;
                acc[4] += c1[0] * wv; acc[5] += c1[1] * wv; acc[6] += c1[2] * wv; acc[7] += c1[3] * wv;
                acc[8] += c2[0] * wv; acc[9] += c2[1] * wv; acc[10] += c2[2] * wv; acc[11] += c2[3] * wv;
                acc[12] += c3[0] * wv; acc[13] += c3[1] * wv; acc[14] += c3[2] * wv; acc[15] += c3[3] * wv;
                acd[0] += c0[0] * wu; acd[1] += c0[1] * wu; acd[2] += c0[2] * wu; acd[3] += c0[3] * wu;
                acd[4] += c1[0] * wu; acd[5] += c1[1] * wu; acd[6] += c1[2] * wu; acd[7] += c1[3] * wu;
                acd[8] += c2[0] * wu; acd[9] += c2[1] * wu; acd[10] += c2[2] * wu; acd[11] += c2[3] * wu;
                acd[12] += c3[0] * wu; acd[13] += c3[1] * wu; acd[14] += c3[2] * wu; acd[15] += c3[3] * wu;
            }
#pragma unroll
            for (int b = 0; b < 16; ++b) { red[(F.wave * 16 + b) * 96 + F.lane] = acc[b]; if (F.lane < 32) red[(F.wave * 16 + b) * 96 + 64 + F.lane] = acd[b]; }
            __syncthreads();
            GAS float* cond = (GAS float*)(F.ws + WS_COND) + (size_t)l * BATCH * NCOND;
            for (int o = F.tid; o < 16 * 96; o += 512) { const int b = o / 96, cl = o % 96; float s = INP(F, 4)[(size_t)l * NCOND + col0 + cl];
#pragma unroll
                for (int w = 0; w < 8; ++w) s += red[(w * 16 + b) * 96 + cl];
                cond[(size_t)b * NCOND + col0 + cl] = s; }
            __syncthreads();
        }
        __syncthreads();
    }
    if (F.vcu < 16 * DEPTH) {
        const int part = F.vcu & 7, lk = F.vcu >> 3, l = lk >> 1, kind = lk & 1;
        LAS float* red = (LAS float*)(F.lds + 65536);
        const GAS float* W1 = INP(F, kind ? 12 : 9) + (size_t)l * 2048 * 256 + 4 * F.lane;
        const GAS float* pe = INP(F, kind ? 14 : 11) + (size_t)l * 2048;
        const int kbeg = part * 256 + F.wave * 32;
        f32x4 wv[32];
#pragma unroll
        for (int i = 0; i < 32; ++i) wv[i] = *(const GAS f32x4*)(W1 + (size_t)(kbeg + i) * 256);
        f32x4 a4 = (f32x4){0.f, 0.f, 0.f, 0.f};
#pragma unroll
        for (int i = 0; i < 32; ++i) a4 += wv[i] * pe[kbeg + i];
        *(LAS f32x4*)(red + F.wave * 256 + 4 * F.lane) = a4;
        __syncthreads();
        if (F.tid < 256) { float sum = 0.f;
#pragma unroll
            for (int w = 0; w < 8; ++w) sum += red[w * 256 + F.tid];
            ((GAS float*)(F.ws + WS_CW + CW_B1))[(lk * 8 + part) * 256 + F.tid] = sum; }
        __syncthreads();
    }
    {
        const GAS int* pos = (const GAS int*)INP(F, 2);
        GAS float* rc = (GAS float*)(F.ws + WS_ROPEC); GAS float* rs = (GAS float*)(F.ws + WS_ROPES);
        const float invf = (float)exp2(-(double)(gtid & 31) * (13.287712379549449 / 32.0));
        int pv[8];
#pragma unroll
        for (int j = 0; j < 8; ++j) { const int idx = gtid + j * NT; pv[j] = (idx < MROWS * 32) ? pos[idx >> 5] : 0; }
#pragma unroll
        for (int j = 0; j < 8; ++j) { const int idx = gtid + j * NT;
            if (idx < MROWS * 32) {
                const float ang = (float)pv[j] * invf;
                const double rev = (double)ang * 0.15915494309189535; const float fr = (float)(rev - floor(rev));
                rc[idx] = __builtin_amdgcn_cosf(fr); rs[idx] = __builtin_amdgcn_sinf(fr); } }
        for (int idx = gtid + 8 * NT; idx < MROWS * 32; idx += NT) {
            const int row = idx >> 5;
            const float ang = (float)pos[row] * invf;
            const double rev = (double)ang * 0.15915494309189535; const float fr = (float)(rev - floor(rev));
            rc[idx] = __builtin_amdgcn_cosf(fr); rs[idx] = __builtin_amdgcn_sinf(fr);
        }
    }
    {
        GAS float* bp = (GAS float*)(F.ws + WS_BINP);
        for (int idx = gtid; idx < DEPTH * NPAD; idx += NT) { const int l = idx / NPAD, p = idx % NPAD; const int c = cmap_in(p); bp[idx] = (c >= 0) ? INP(F, 7)[(size_t)l * INW + c] : 0.f; }
    }
    {
        LAS float* scr = (LAS float*)(F.lds + F.wave * 16384);
        constexpr int I_IN = 16 * 160, I_UP = 8 * 32, I_O = 16 * 32, I_F1 = 16 * 128, I_F2 = 64 * 32, I_C1 = 32 * 8, I_C2 = 4 * 2, I_L = I_IN + 2 * I_UP + I_O + I_F1 + I_F2 + 2 * I_C1 + 2 * I_C2;
        auto desc = [&](int it) -> TrDesc {
            const int l = it / I_L; int r = it % I_L;
            GAS unsigned char* wl = F.ws + WS_W + (size_t)l * W_LAYER; GAS unsigned char* cw = F.ws + WS_CW;
            TrDesc d; d.mapped = false; d.kdst0 = 0;
            if (r < I_IN) { d.W = INP(F, 6) + (size_t)l * DM * INW; d.ldw = INW; d.nblk = 160; d.WT = (GAS bf16*)(wl + W_IN); d.ldt = DM; d.mapped = true; d.item = r; return d; } r -= I_IN;
            if (r < I_UP) { d.W = INP(F, 15) + (size_t)l * 512 * DM; d.ldw = DM; d.nblk = 32; d.WT = (GAS bf16*)(wl + W_UP); d.ldt = DM; d.item = r; return d; } r -= I_UP;
            if (r < I_UP) { d.W = INP(F, 16) + (size_t)l * 512 * DM; d.ldw = DM; d.nblk = 32; d.WT = (GAS bf16*)(wl + W_UP); d.ldt = DM; d.kdst0 = 512; d.item = r; return d; } r -= I_UP;
            if (r < I_O) { d.W = INP(F, 17) + (size_t)l * DM * DM; d.ldw = DM; d.nblk = 32; d.WT = (GAS bf16*)(wl + W_O); d.ldt = DM; d.item = r; return d; } r -= I_O;
            if (r < I_F1) { d.W = INP(F, 19) + (size_t)l * DM * DFF; d.ldw = DFF; d.nblk = 128; d.WT = (GAS bf16*)(wl + W_F1); d.ldt = DM; d.item = r; return d; } r -= I_F1;
            if (r < I_F2) { d.W = INP(F, 20) + (size_t)l * DFF * DM; d.ldw = DM; d.nblk = 32; d.WT = (GAS bf16*)(wl + W_F2); d.ldt = DFF; d.item = r; return d; } r -= I_F2;
            if (r < I_C1) { d.W = INP(F, 9) + (size_t)l * 2048 * 256; d.ldw = 256; d.nblk = 8; d.WT = (GAS bf16*)(cw + CW_W1T) + (size_t)(l * 2 + 0) * 256 * 2048; d.ldt = 2048; d.item = r; return d; } r -= I_C1;
            if (r < I_C1) { d.W = INP(F, 12) + (size_t)l * 2048 * 256; d.ldw = 256; d.nblk = 8; d.WT = (GAS bf16*)(cw + CW_W1T) + (size_t)(l * 2 + 1) * 256 * 2048; d.ldt = 2048; d.item = r; return d; } r -= I_C1;
            if (r < I_C2) { d.W = INP(F, 10) + (size_t)l * 256 * 64; d.ldw = 64; d.nblk = 2; d.WT = (GAS bf16*)(cw + CW_W2T) + (size_t)(l * 2 + 0) * 64 * 256; d.ldt = 256; d.item = r; return d; } r -= I_C2;
            d.W = INP(F, 13) + (size_t)l * 256 * 64; d.ldw = 64; d.nblk = 2; d.WT = (GAS bf16*)(cw + CW_W2T) + (size_t)(l * 2 + 1) * 64 * 256; d.ldt = 256; d.item = r; return d;
        };
        if (gw < DEPTH * I_L) {
            TrDesc dc = desc(gw); TrRegs tc; tr_load(dc, tc, F.lane);
            for (int it = gw; it < DEPTH * I_L; it += NGW) {
                const int nx = it + NGW; const bool more = nx < DEPTH * I_L;
                TrDesc dn = dc; TrRegs tn = tc;
                if (more) { dn = desc(nx); tr_load(dn, tn, F.lane); }
                tr_finish(dc, tc, scr, F.lane);
                dc = dn; tc = tn;
            }
        }
    }
}

__device__ __forceinline__ void norm_mod_phase(Frame& F, const GAS float* x32, const GAS bf16* xr, const GAS float* gvec, const GAS float* cond_l, int sh_chunk, int sc_chunk, GAS bf16* H) {
    const int gw = F.rk * NWAVES + F.wave, NGW = F.nl * NWAVES; const int R0 = F.b0 * SEQ, R1 = R0 + F.nb * SEQ;
    for (int r0 = R0 + gw * 16; r0 < R1; r0 += NGW * 16) {
        const int b = r0 / SEQ;
        f32x4 gc[4], sh[4];
#pragma unroll
        for (int q = 0; q < 4; ++q) { const int col = 512 * (q >> 1) + 8 * F.lane + 4 * (q & 1);
            const f32x4 gv = *(const GAS f32x4*)(gvec + col), sc = *(const GAS f32x4*)(cond_l + (size_t)b * NCOND + sc_chunk * DM + col);
            gc[q] = gv * (sc + 1.0f); sh[q] = *(const GAS f32x4*)(cond_l + (size_t)b * NCOND + sh_chunk * DM + col); }
        for (int r = 0; r < 16; ++r) {
            const int row = r0 + r;
            f32x4 v[4]; float s = 0.f;
            if (x32) {
#pragma unroll
                for (int q = 0; q < 4; ++q) v[q] = *(const GAS f32x4*)(x32 + (size_t)row * DM + 512 * (q >> 1) + 8 * F.lane + 4 * (q & 1));
            } else {
#pragma unroll
                for (int j = 0; j < 2; ++j) { const v4u p = *(const GAS v4u*)(xr + (size_t)row * XRP + 512 * j + 8 * F.lane);
                    v[2 * j] = (f32x4){bf_lo(p.x), bf_hi(p.x), bf_lo(p.y), bf_hi(p.y)}; v[2 * j + 1] = (f32x4){bf_lo(p.z), bf_hi(p.z), bf_lo(p.w), bf_hi(p.w)}; }
            }
#pragma unroll
            for (int q = 0; q < 4; ++q) s += (v[q].x * v[q].x + v[q].y * v[q].y) + (v[q].z * v[q].z + v[q].w * v[q].w);
            const float rs = 1.0f / sqrtf(wave_sum(s) * (1.0f / DM) + EPS);
#pragma unroll
            for (int j = 0; j < 2; ++j) { const f32x4 y0 = v[2 * j] * rs * gc[2 * j] + sh[2 * j], y1 = v[2 * j + 1] * rs * gc[2 * j + 1] + sh[2 * j + 1];
                v4u o; o.x = pk2(y0.x, y0.y); o.y = pk2(y0.z, y0.w); o.z = pk2(y1.x, y1.y); o.w = pk2(y1.z, y1.w);
                *(GAS v4u*)(H + (size_t)row * DM + 512 * j + 8 * F.lane) = o; }
        }
    }
}
__device__ __forceinline__ void final_norm_phase(Frame& F, const GAS bf16* xr, const GAS float* gvec, GAS float* out) {
    const int gw = F.rk * NWAVES + F.wave, NGW = F.nl * NWAVES; const int R0 = F.b0 * SEQ, R1 = R0 + F.nb * SEQ;
    f32x4 gc[4];
#pragma unroll
    for (int q = 0; q < 4; ++q) gc[q] = *(const GAS f32x4*)(gvec + 512 * (q >> 1) + 8 * F.lane + 4 * (q & 1));
    for (int row = R0 + gw; row < R1; row += NGW) {
        f32x4 v[4]; float s = 0.f;
#pragma unroll
        for (int j = 0; j < 2; ++j) { const v4u p = *(const GAS v4u*)(xr + (size_t)row * XRP + 512 * j + 8 * F.lane);
            v[2 * j] = (f32x4){bf_lo(p.x), bf_hi(p.x), bf_lo(p.y), bf_hi(p.y)}; v[2 * j + 1] = (f32x4){bf_lo(p.z), bf_hi(p.z), bf_lo(p.w), bf_hi(p.w)}; }
#pragma unroll
        for (int q = 0; q < 4; ++q) s += (v[q].x * v[q].x + v[q].y * v[q].y) + (v[q].z * v[q].z + v[q].w * v[q].w);
        const float rs = 1.0f / sqrtf(wave_sum(s) * (1.0f / DM) + EPS);
        asm volatile("s_waitcnt vmcnt(0)" ::: "memory");
#pragma unroll
        for (int q = 0; q < 4; ++q) *(GAS f32x4*)(out + (size_t)row * DM + 512 * (q >> 1) + 8 * F.lane + 4 * (q & 1)) = v[q] * rs * gc[q];
    }
}
__device__ __forceinline__ void unpack8(const v4u u, float (&f)[8]) { f[0] = bf_lo(u.x); f[1] = bf_hi(u.x); f[2] = bf_lo(u.y); f[3] = bf_hi(u.y); f[4] = bf_lo(u.z); f[5] = bf_hi(u.z); f[6] = bf_lo(u.w); f[7] = bf_hi(u.w); }
__device__ __forceinline__ void conv_phase(Frame& F, const GAS bf16* ZC_, const GAS float* cw  , GAS bf16* CV  , int blk, int nblk) {
    const int gw = blk * NWAVES + F.wave, NGW = nblk * NWAVES; const int c8 = 8 * F.lane; const int R0 = F.b0 * SEQ, R1 = R0 + F.nb * SEQ;
    float w0[8], w1[8], w2[8];
#pragma unroll
    for (int i = 0; i < 8; ++i) { w0[i] = cw[c8 + i]; w1[i] = cw[512 + c8 + i]; w2[i] = cw[1024 + c8 + i]; }
    const GAS bf16* ZCb = ZC_;
    for (int r0 = R0 + gw * 16; r0 < R1; r0 += NGW * 16) {
        const int t0 = r0 % SEQ; const GAS bf16* ZC = ZCb + (size_t)(r0 / SEQ) * XE_ZC;
        float vm2[8], vm1[8];
#pragma unroll
        for (int i = 0; i < 8; ++i) { vm2[i] = 0.f; vm1[i] = 0.f; }
        if (t0 >= 2) {
            float a[8], b[8];
            unpack8(*(const GAS v4u*)(ZC + (size_t)(r0 - 2) * 1536 + 512 + c8), a); unpack8(*(const GAS v4u*)(ZC + (size_t)(r0 - 2) * 1536 + 1024 + c8), b);
#pragma unroll
            for (int i = 0; i < 8; ++i) vm2[i] = a[i] * b[i];
            unpack8(*(const GAS v4u*)(ZC + (size_t)(r0 - 1) * 1536 + 512 + c8), a); unpack8(*(const GAS v4u*)(ZC + (size_t)(r0 - 1) * 1536 + 1024 + c8), b);
#pragma unroll
            for (int i = 0; i < 8; ++i) vm1[i] = a[i] * b[i];
        }
#pragma unroll 1
        for (int r = 0; r < 16; r += 4) {
            v4u lg[4], la[4], lb[4];
#pragma unroll
            for (int q = 0; q < 4; ++q) { const size_t row = (size_t)(r0 + r + q);
                lg[q] = *(const GAS v4u*)(ZC + row * 1536 + c8); la[q] = *(const GAS v4u*)(ZC + row * 1536 + 512 + c8); lb[q] = *(const GAS v4u*)(ZC + row * 1536 + 1024 + c8); }
            asm volatile("" ::: "memory");
#pragma unroll
            for (int q = 0; q < 4; ++q) { const size_t row = (size_t)(r0 + r + q);
                float a[8], b[8], g[8], y[8];
                unpack8(lg[q], g); unpack8(la[q], a); unpack8(lb[q], b);
#pragma unroll
                for (int i = 0; i < 8; ++i) { const float v = a[i] * b[i]; y[i] = g[i] * (w0[i] * vm2[i] + w1[i] * vm1[i] + w2[i] * v); vm2[i] = vm1[i]; vm1[i] = v; }
                v4u o; o.x = pk2(y[0], y[1]); o.y = pk2(y[2], y[3]); o.z = pk2(y[4], y[5]); o.w = pk2(y[6], y[7]);
                *(GAS v4u*)(CV + row * 1024 + c8) = o; }
            asm volatile("" ::: "memory");
        }
    }
}
__device__ __forceinline__ void compress_phase(Frame& F, int l, const GAS bf16* KV, GAS bf16* KCMP, GAS bf16* VCMP) {
    const int gw = F.vcu * NWAVES + F.wave, NGW = F.G * NWAVES; const int lane = F.lane;
    for (int unit = gw; unit < 2 * BATCH * 2 * 16; unit += NGW) {
        const int cg = unit & 15, g = (unit >> 4) & 1, b = (unit >> 5) & 15, kind = unit >> 9, c0 = cg * 8;
        const GAS float* W1 = INP(F, kind ? 12 : 9) + (size_t)l * 2048 * 256;
        const GAS float* W2 = INP(F, kind ? 13 : 10) + (size_t)l * 256 * 64;
        const GAS float* pe = INP(F, kind ? 14 : 11) + (size_t)l * 32 * 64;
        const GAS bf16* src = KV + (size_t)b * SEQ * 768 + kind * 128 + g * 64 + lane;
        float acc[8][4];
#pragma unroll
        for (int r = 0; r < 8; ++r)
#pragma unroll
            for (int i = 0; i < 4; ++i) acc[r][i] = 0.f;
        for (int lq = 0; lq < 32; ++lq) {
            const float pev = pe[lq * 64 + lane];
            float xv[8];
#pragma unroll
            for (int r = 0; r < 8; ++r) { int tok = 16 * (c0 + r) + lq; tok = tok > SEQ - 1 ? SEQ - 1 : tok; xv[r] = bf2f(src[(size_t)tok * 768]) + pev; }
            const GAS float* w1p = W1 + (size_t)lq * 64 * 256 + 4 * lane;
#pragma unroll 4
            for (int d = 0; d < 64; ++d) {
                const f32x4 w4 = *(const GAS f32x4*)(w1p + (size_t)d * 256);
#pragma unroll
                for (int r = 0; r < 8; ++r) { const float x = rdlane(xv[r], d); acc[r][0] += x * w4[0]; acc[r][1] += x * w4[1]; acc[r][2] += x * w4[2]; acc[r][3] += x * w4[3]; }
            }
        }
#pragma unroll
        for (int r = 0; r < 8; ++r)
#pragma unroll
            for (int i = 0; i < 4; ++i) { const float a = acc[r][i]; acc[r][i] = a * sigmoidf_(a); }
        float o[8];
#pragma unroll
        for (int r = 0; r < 8; ++r) o[r] = 0.f;
        for (int jj = 0; jj < 64; ++jj) {
#pragma unroll
            for (int i = 0; i < 4; ++i) { const float w = W2[(size_t)(4 * jj + i) * 64 + lane];
#pragma unroll
                for (int r = 0; r < 8; ++r) o[r] += rdlane(acc[r][i], jj) * w; }
        }
        GAS bf16* dst = (kind ? VCMP : KCMP) + ((size_t)(b * 2 + g) * 128 + c0) * 64 + lane;
#pragma unroll
        for (int r = 0; r < 8; ++r) dst[r * 64] = (c0 + r < NCMP) ? (bf16)(pk2(o[r], 0.f) & 0xffffu) : (bf16)0;
    }
}

__device__ __forceinline__ void dot4(const GAS bf16* krow, const LAS float* qs, float (&s)[4]) {
#pragma unroll
    for (int h = 0; h < 4; ++h) s[h] = 0.f;
#pragma unroll
    for (int c8 = 0; c8 < 8; ++c8) {
        asm volatile("" ::: "memory");
        float k[8]; unpack8(*(const GAS v4u*)(krow + 8 * c8), k);
#pragma unroll
        for (int h = 0; h < 4; ++h) { const f32x4 qa = *(const LAS f32x4*)(qs + h * 64 + 8 * c8), qb = *(const LAS f32x4*)(qs + h * 64 + 8 * c8 + 4);
            s[h] += (k[0] * qa[0] + k[1] * qa[1]) + (k[2] * qa[2] + k[3] * qa[3]) + (k[4] * qb[0] + k[5] * qb[1]) + (k[6] * qb[2] + k[7] * qb[3]); }
    }
}
__device__ __forceinline__ void attn_tile(const GAS bf16* kbase, const GAS bf16* vbase, size_t pitch, int key0, bool valid, int jmax, const LAS float* qs, int lane, float (&m)[4], float (&l)[4], float (&o)[4]) {
    float s[4]; dot4(kbase + (size_t)(key0 + lane) * pitch, qs, s);
    float p[4];
#pragma unroll
    for (int h = 0; h < 4; ++h) {
        const float sv = valid ? s[h] : -INFINITY;
        const float mt = wave_max(sv), mn = fmaxf(m[h], mt);
        const float alpha = (m[h] == -INFINITY) ? 0.f : fast_exp2(m[h] - mn);
        p[h] = (valid && mn > -INFINITY) ? fast_exp2(sv - mn) : 0.f;
        l[h] = l[h] * alpha + wave_sum(p[h]); o[h] *= alpha; m[h] = mn;
    }
    for (int j = 0; j <= jmax; ++j) {
        const float v = bf2f(vbase[(size_t)(key0 + j) * pitch + lane]);
#pragma unroll
        for (int h = 0; h < 4; ++h) o[h] += rdlane(p[h], j) * v;
    }
}
__device__ __forceinline__ void attn_naive_phase(Frame& F, const GAS bf16* Q, const GAS bf16* KV, const GAS bf16* KCMP, const GAS bf16* VCMP, const GAS float* NG, GAS bf16* AO  ) {
    const int gw = F.vcu * NWAVES + F.wave, NGW = F.G * NWAVES; const int lane = F.lane;
    LAS float* qs = (LAS float*)(F.lds + F.wave * 2048);
    LAS float* ps = qs + 256;
    for (int unit = gw; unit < MROWS * 2; unit += NGW) {
        const int row = unit >> 1, g = unit & 1, b = row / SEQ, t = row % SEQ;
        asm volatile("" ::: "memory");
#pragma unroll
        for (int h = 0; h < 4; ++h) qs[h * 64 + lane] = bf2f(Q[(size_t)row * 512 + (g * 4 + h) * 64 + lane]);
        LDS_WAIT();
        float outv[4];
        float gate[3][4];
#pragma unroll
        for (int br = 0; br < 3; ++br)
#pragma unroll
            for (int h = 0; h < 4; ++h) gate[br][h] = sigmoidf_(NG[(size_t)row * 24 + br * 8 + g * 4 + h]);
        const int cmax = (t >= 31) ? ((t - 31) >> 4) : -1;
        const GAS bf16* kc = KCMP + (size_t)(b * 2 + g) * 128 * 64; const GAS bf16* vc = VCMP + (size_t)(b * 2 + g) * 128 * 64;
        float p0[4], p1[4];
        {
            float s0[4], s1[4];
            dot4(kc + (size_t)lane * 64, qs, s0); dot4(kc + (size_t)(64 + lane) * 64, qs, s1);
            const bool v0 = lane <= cmax, v1 = 64 + lane <= cmax;
#pragma unroll
            for (int h = 0; h < 4; ++h) {
                const float a = v0 ? s0[h] : -INFINITY, c = v1 ? s1[h] : -INFINITY;
                const float mx = wave_max(fmaxf(a, c));
                const float e0 = v0 ? fast_exp2(a - mx) : 0.f, e1 = v1 ? fast_exp2(c - mx) : 0.f;
                const float sum = wave_sum(e0 + e1); const float inv = (cmax >= 0) ? 1.0f / sum : 0.f;
                p0[h] = e0 * inv; p1[h] = e1 * inv;
            }
            float oc[4] = {0.f, 0.f, 0.f, 0.f};
            for (int c = 0; c <= cmax; ++c) {
                const float v = bf2f(vc[(size_t)c * 64 + lane]);
#pragma unroll
                for (int h = 0; h < 4; ++h) { const float pc = (c < 64) ? rdlane(p0[h], c & 63) : rdlane(p1[h], c & 63); oc[h] += pc * v; }
            }
#pragma unroll
            for (int h = 0; h < 4; ++h) outv[h] = gate[0][h] * oc[h];
        }
        unsigned selmask = 0u;
        {
            ps[lane] = (p0[0] + p0[1]) + (p0[2] + p0[3]); ps[64 + lane] = (p1[0] + p1[1]) + (p1[2] + p1[3]);
            LDS_WAIT();
            const int blk_t = t >> 6, n = lane;
            float imp = 0.f;
#pragma unroll
            for (int i = -1; i <= 3; ++i) { const int c = 4 * n + i; if (n < 32 && c >= 0 && c <= 126) imp += ps[c]; }
            const bool vn = (n < 32) && (n <= blk_t), forced = (n == 0) || (n == blk_t) || (n == blk_t - 1);
            float val = (n < 32) ? (vn ? imp + (forced ? 1e4f : 0.f) : -1.0f) : -INFINITY;
            for (int k = 0; k < 8; ++k) {
                const float mx = wave_max(val);
                const unsigned long long bal = __ballot(val == mx);
                const int idx = __ffsll((long long)bal) - 1;
                selmask |= 1u << idx;
                if (lane == idx) val = -INFINITY;
            }
            selmask = (unsigned)__builtin_amdgcn_readfirstlane((int)selmask);
        }
        const GAS bf16* kvb = KV + (size_t)b * SEQ * 768 + g * 64;
        {
            float m[4], l[4], o[4];
#pragma unroll
            for (int h = 0; h < 4; ++h) { m[h] = -INFINITY; l[h] = 0.f; o[h] = 0.f; }
            const int blk_t = t >> 6;
            for (int n = 0; n <= blk_t; ++n) {
                if (!((selmask >> n) & 1u)) continue;
                const int key0 = 64 * n; const bool valid = key0 + lane <= t; const int jmax = (t - key0) < 63 ? (t - key0) : 63;
                attn_tile(kvb + 256, kvb + 384, 768, key0, valid, jmax, qs, lane, m, l, o);
            }
#pragma unroll
            for (int h = 0; h < 4; ++h) outv[h] += gate[1][h] * o[h] / l[h];
        }
        {
            float m[4], l[4], o[4];
#pragma unroll
            for (int h = 0; h < 4; ++h) { m[h] = -INFINITY; l[h] = 0.f; o[h] = 0.f; }
            const int nlo = (t - 511) > 0 ? ((t - 511) >> 6) : 0;
            for (int n = t >> 6; n >= nlo; --n) {
                const int key0 = 64 * n; const int key = key0 + lane; const bool valid = (key <= t) && (key > t - 512); const int jmax = (t - key0) < 63 ? (t - key0) : 63;
                attn_tile(kvb + 512, kvb + 640, 768, key0, valid, jmax, qs, lane, m, l, o);
            }
#pragma unroll
            for (int h = 0; h < 4; ++h) outv[h] += gate[2][h] * o[h] / l[h];
        }
#pragma unroll
        for (int h = 0; h < 4; ++h) AO[(size_t)row * 1024 + (g * 4 + h) * 64 + lane] = (bf16)(pk2(outv[h], 0.f) & 0xffffu);
    }
}

typedef short bf16x8_t __attribute__((ext_vector_type(8)));
typedef short bf16x4_t __attribute__((ext_vector_type(4)));
typedef float f32x16 __attribute__((ext_vector_type(16)));
constexpr int AT_SLOT = 8192, AT_KRING = 0, AT_VRING = 4 * AT_SLOT;
typedef short at_s4 __attribute__((ext_vector_type(4)));
__device__ __forceinline__ void at_dma(const GAS unsigned char* gsrc, LAS unsigned char* dst) {
    unsigned keep; const unsigned ldsa = (unsigned)__builtin_amdgcn_readfirstlane((int)(unsigned)(__UINTPTR_TYPE__)dst);
    asm volatile("s_mov_b32 %0, m0\n\ts_mov_b32 m0, %2\n\ts_nop 0\n\tglobal_load_lds_dwordx4 %1, off\n\ts_mov_b32 m0, %0" : "=&s"(keep) : "v"(gsrc), "s"(ldsa) : "memory");
}
__device__ __forceinline__ void at_dma_tile(LAS unsigned char* ring, int slot, int w, const GAS unsigned char* kb, const GAS unsigned char* vb, unsigned koff, unsigned voff) {
    at_dma(kb + koff, ring + AT_KRING + slot * AT_SLOT + w * 1024);
    at_dma(vb + voff, ring + AT_VRING + slot * AT_SLOT + w * 1024);
}
#define AT_WAIT_BAR(N) asm volatile("s_waitcnt vmcnt(" #N ") lgkmcnt(0)\n\ts_barrier" ::: "memory")
__device__ __forceinline__ bf16x8_t at_vfrag(const LAS unsigned char* p) {
    const at_s4 lo = __builtin_bit_cast(at_s4, __builtin_amdgcn_ds_read_tr16_b64_v4i16((LAS at_s4*)p));
    const at_s4 hi = __builtin_bit_cast(at_s4, __builtin_amdgcn_ds_read_tr16_b64_v4i16((LAS at_s4*)(p + 512)));
    return __builtin_shufflevector(lo, hi, 0, 1, 2, 3, 4, 5, 6, 7);
}
__device__ __forceinline__ void at_qk(const LAS unsigned char* kslot, const LAS unsigned char* qp, int l31, int hi, f32x16 (&s)[2]) {
#pragma unroll
    for (int kh = 0; kh < 2; ++kh) {
        f32x16 acc = (f32x16){0.f, 0.f, 0.f, 0.f, 0.f, 0.f, 0.f, 0.f, 0.f, 0.f, 0.f, 0.f, 0.f, 0.f, 0.f, 0.f};
#pragma unroll
        for (int ks = 0; ks < 4; ++ks) {
            const bf16x8_t kf = *(const LAS bf16x8_t*)(kslot + (2 * ks + hi) * 1024 + (32 * kh + l31) * 16);
            acc = __builtin_amdgcn_mfma_f32_32x32x16_bf16(kf, *(const LAS bf16x8_t*)(qp + ks * 1024), acc, 0, 0, 0);
        }
        s[kh] = acc;
    }
}
__device__ __forceinline__ void at_pv(const LAS unsigned char* vslot, int vp0, const bf16x8_t (&pf)[2][2], f32x16 (&o)[2]) {
#pragma unroll
    for (int dh = 0; dh < 2; ++dh)
#pragma unroll
        for (int kh = 0; kh < 2; ++kh)
#pragma unroll
            for (int s2 = 0; s2 < 2; ++s2)
                o[dh] = __builtin_amdgcn_mfma_f32_32x32x16_bf16(at_vfrag(vslot + vp0 + dh * 4096 + (2 * kh + s2) * 1024), pf[kh][s2], o[dh], 0, 0, 0);
}
__device__ __forceinline__ void at_pack(const f32x16 (&p)[2], bf16x8_t (&pf)[2][2]) {
#pragma unroll
    for (int kh = 0; kh < 2; ++kh)
#pragma unroll
        for (int s2 = 0; s2 < 2; ++s2) {
            v4u w; w.x = pk2(p[kh][8 * s2 + 0], p[kh][8 * s2 + 1]); w.y = pk2(p[kh][8 * s2 + 2], p[kh][8 * s2 + 3]);
            w.z = pk2(p[kh][8 * s2 + 4], p[kh][8 * s2 + 5]); w.w = pk2(p[kh][8 * s2 + 6], p[kh][8 * s2 + 7]);
            pf[kh][s2] = __builtin_bit_cast(bf16x8_t, w);
        }
}
typedef unsigned at_u2 __attribute__((ext_vector_type(2)));
__device__ __forceinline__ float xhalf_max(float v) { const at_u2 r = __builtin_amdgcn_permlane32_swap(__float_as_uint(v), __float_as_uint(v), false, false); return fmaxf(__uint_as_float(r.x), __uint_as_float(r.y)); }
__device__ __forceinline__ float xhalf_sum(float v) { const at_u2 r = __builtin_amdgcn_permlane32_swap(__float_as_uint(v), __float_as_uint(v), false, false); return __uint_as_float(r.x) + __uint_as_float(r.y); }
__device__ __forceinline__ float xhalf(float v) { const at_u2 r = __builtin_amdgcn_permlane32_swap(__float_as_uint(v), __float_as_uint(v), false, false); const bool up = (__builtin_amdgcn_mbcnt_hi(~0u, __builtin_amdgcn_mbcnt_lo(~0u, 0u)) >= 32u); return __uint_as_float(up ? r.x : r.y); }
__device__ __forceinline__ float dpp_xor1(float v) { return __int_as_float(__builtin_amdgcn_mov_dpp(__float_as_int(v), 0xB1, 0xF, 0xF, true)); }
__device__ __forceinline__ float dpp_xor2(float v) { return __int_as_float(__builtin_amdgcn_mov_dpp(__float_as_int(v), 0x4E, 0xF, 0xF, true)); }
__device__ __forceinline__ int crow16(int r, int hi) { return (r & 3) + 8 * (r >> 2) + 4 * hi; }
constexpr float AT_THR = 8.0f;
constexpr int AT_OUT_OFF = 8 * AT_SLOT;
constexpr int AT_Q_OFF = AT_OUT_OFF + 8 * 4096;

struct AtUnitCtx { int qt, nitems, iq, l31, hi, tid, w, vp0; unsigned selmask; const GAS unsigned char* kvb; unsigned koff_kv, voff_kv; float gate1, gate2; };
__device__ __forceinline__ void at_item(const AtUnitCtx& c, int it, int& n, bool& is_win) { is_win = it > c.qt; n = is_win ? (c.qt - (it - c.qt - 1)) : it; }
__device__ __forceinline__ void at_step(const AtUnitCtx& c, LAS unsigned char* ring, LAS unsigned* outw, int it, int bcur, const LAS unsigned char* qp,
                                        f32x16 (&scur)[2], f32x16 (&snext)[2], float& m, float& l, f32x16 (&o)[2], int lane, f32x16& negm, float& mq) {
    const bool has3 = it + 3 < c.nitems;
    if (has3) { int n3; bool w3; at_item(c, it + 3, n3, w3); const GAS unsigned char* tb = c.kvb + (size_t)n3 * 98304 + (w3 ? 1024 : 512); at_dma_tile(ring, (it + 3) & 3, c.w, tb, tb + 256, c.koff_kv, c.voff_kv); }
    const LAS unsigned char* cur = ring + AT_VRING + (it & 3) * AT_SLOT; const LAS unsigned char* nxt = ring + AT_KRING + ((it + 1) & 3) * AT_SLOT;
    int n; bool is_win;
    at_item(c, it, n, is_win);
    const bool sel_here = is_win || ((c.selmask >> n) & 1u);
    const LAS unsigned char* kb = nxt + c.hi * 1024 + c.l31 * 16;
    const LAS unsigned char* vb = cur + c.vp0;
#define AT_KF(kh, ks) (*(const LAS bf16x8_t*)(kb + (ks) * 2048 + (kh) * 512))
#define AT_VF(dh, g) at_vfrag(vb + (dh) * 4096 + (g) * 1024)
    bf16x8_t kfa[4], kfb[4], vfa[4], vfb[4];
    float strow = 0.f;
    if (!is_win && !__any(sel_here)) {
#pragma unroll
        for (int g = 0; g < 4; ++g) { kfa[g] = AT_KF(0, g); kfb[g] = AT_KF(1, g); }
#pragma unroll
        for (int g = 0; g < 4; ++g) { const bf16x8_t qg = *(const LAS bf16x8_t*)(qp + g * 1024);
            snext[0] = __builtin_amdgcn_mfma_f32_32x32x16_bf16(kfa[g], qg, g == 0 ? negm : snext[0], 0, 0, 0);
            snext[1] = __builtin_amdgcn_mfma_f32_32x32x16_bf16(kfb[g], qg, g == 0 ? negm : snext[1], 0, 0, 0); }
    } else {
    kfa[0] = AT_KF(0, 0); kfb[0] = AT_KF(1, 0); vfa[0] = AT_VF(0, 0); vfb[0] = AT_VF(1, 0);
    const bool diag = (n == c.qt), lowedge = is_win && (n == c.qt - 8);
    if (diag || lowedge) {
        int iqv = c.iq; asm volatile("" : "+v"(iqv));
        const int jhi = (diag ? iqv : 63) - 4 * c.hi, jlo = (lowedge ? iqv : -1) - 4 * c.hi;
#pragma unroll
        for (int kh = 0; kh < 2; ++kh)
#pragma unroll
            for (int i = 0; i < 16; ++i) { const int j = 32 * kh + crow16(i, 0); const bool ok = (j <= jhi) && (j > jlo); scur[kh][i] = ok ? scur[kh][i] : -INFINITY; }
    }
    float mx = -INFINITY;
#pragma unroll
    for (int kh = 0; kh < 2; ++kh)
#pragma unroll
        for (int i = 0; i < 16; ++i) mx = fmaxf(mx, scur[kh][i]);
    mx = sel_here ? xhalf_max(mx) + mq : -INFINITY;
    if (__any(mx > m + AT_THR)) {
        const float mn = fmaxf(m, mx); const float alpha = fast_exp2(m - mn);
        l *= alpha; m = mn;
#pragma unroll
        for (int dh = 0; dh < 2; ++dh)
#pragma unroll
            for (int i = 0; i < 16; ++i) o[dh][i] *= alpha;
        const float dm = sel_here ? (mn - mq) : 0.f;
#pragma unroll
        for (int kh = 0; kh < 2; ++kh)
#pragma unroll
            for (int i = 0; i < 16; ++i) scur[kh][i] -= dm;
        const float nm = (mn == -INFINITY) ? 0.f : -mn;
#pragma unroll
        for (int i = 0; i < 16; ++i) negm[i] = nm;
        asm volatile("" : "+v"(negm));
    }
    const unsigned keep = (is_win || sel_here) ? 0xffffffffu : 0u;
    float sumg[4];
#pragma unroll
    for (int g = 0; g < 4; ++g) {
        if (g < 3) { kfa[g + 1] = AT_KF(0, g + 1); kfb[g + 1] = AT_KF(1, g + 1); vfa[g + 1] = AT_VF(0, g + 1); vfb[g + 1] = AT_VF(1, g + 1); }
        const int kh = g >> 1, s2 = g & 1;
        float e[8];
#pragma unroll
        for (int j = 0; j < 8; ++j) e[j] = fast_exp2(scur[kh][8 * s2 + j]);
        sumg[g] = ((e[0] + e[1]) + (e[2] + e[3])) + ((e[4] + e[5]) + (e[6] + e[7]));
        v4u w; w.x = pk2(e[0], e[1]); w.y = pk2(e[2], e[3]); w.z = pk2(e[4], e[5]); w.w = pk2(e[6], e[7]);
        if (!is_win) { w.x &= keep; w.y &= keep; w.z &= keep; w.w &= keep; }
        const bf16x8_t pfg = __builtin_bit_cast(bf16x8_t, w);
        const bf16x8_t qg = *(const LAS bf16x8_t*)(qp + g * 1024);
        snext[0] = __builtin_amdgcn_mfma_f32_32x32x16_bf16(kfa[g], qg, g == 0 ? negm : snext[0], 0, 0, 0);
        snext[1] = __builtin_amdgcn_mfma_f32_32x32x16_bf16(kfb[g], qg, g == 0 ? negm : snext[1], 0, 0, 0);
        o[0] = __builtin_amdgcn_mfma_f32_32x32x16_bf16(vfa[g], pfg, o[0], 0, 0, 0);
        o[1] = __builtin_amdgcn_mfma_f32_32x32x16_bf16(vfb[g], pfg, o[1], 0, 0, 0);
    }
    { const float st = (sumg[0] + sumg[1]) + (sumg[2] + sumg[3]); strow = (is_win || sel_here) ? st : 0.f; }
    }
#undef AT_KF
#undef AT_VF
    l += strow;
    mq = -negm[0];
    if (it == c.qt || it == c.nitems - 1) {
        const float lt = xhalf_sum(l); const float sc = ((it == c.qt) ? c.gate1 : c.gate2) * __builtin_amdgcn_rcpf(lt);
        unsigned t[16];
#pragma unroll
        for (int i = 0; i < 16; ++i) t[i] = outw[i * 64 + lane];
#pragma unroll
        for (int dh = 0; dh < 2; ++dh)
#pragma unroll
            for (int pr = 0; pr < 8; ++pr) { const unsigned pv = t[dh * 8 + pr];
                outw[(dh * 8 + pr) * 64 + lane] = pk2(bf_lo(pv) + sc * o[dh][2 * pr], bf_hi(pv) + sc * o[dh][2 * pr + 1]); o[dh][2 * pr] = 0.f; o[dh][2 * pr + 1] = 0.f; }
        m = -INFINITY; l = 0.f;
    }
    if (has3) AT_WAIT_BAR(2); else AT_WAIT_BAR(0);
}

__device__ __forceinline__ void attn_unit(Frame& F, int b, int g, int qt, const GAS bf16* Q, const GAS bf16* KV, const GAS bf16* KCMP, const GAS bf16* VCMP, const GAS float* NG, GAS bf16* AO) {
    int tid_ = F.tid; asm volatile("" : "+v"(tid_));
    const int tid = tid_, lane = tid & 63, w = F.wave, l31 = lane & 31, hi = lane >> 5;
    const int iq = 8 * w + (l31 >> 2), head = l31 & 3;
    const int t = 64 * qt + iq; const size_t row = (size_t)b * SEQ + t;
    LAS unsigned char* ring = F.lds;
    LAS unsigned* outw = (LAS unsigned*)(F.lds + AT_OUT_OFF + w * 4096);
    LAS unsigned char* qp = F.lds + AT_Q_OFF + w * 4096 + lane * 16;
    const unsigned vrow = 16u * (unsigned)(w & 3) + (unsigned)(lane >> 2), vcol = (unsigned)(w >> 2) * 64u + (unsigned)(lane & 3) * 16u;
    const unsigned koff_kv = (unsigned)lane * 1536u + 16u * (unsigned)w, voff_kv = vrow * 1536u + vcol;
    const unsigned koff_c = (unsigned)lane * 128u + 16u * (unsigned)w, voff_c = vrow * 128u + vcol;
    const int vp0 = ((lane >> 4) & 1) * 32 + (lane & 3) * 8 + (4 * hi + ((lane & 15) >> 2)) * 64;
    const GAS unsigned char* kc = (const GAS unsigned char*)(KCMP + (size_t)(b * 2 + g) * 128 * 64); const GAS unsigned char* vc = (const GAS unsigned char*)(VCMP + (size_t)(b * 2 + g) * 128 * 64);
    const GAS unsigned char* kvb = (const GAS unsigned char*)(KV + (size_t)b * SEQ * 768 + g * 64);
    const bool two_cmp = (4 * qt + 2) >= 64;
    const int nwin = (qt < 8) ? qt + 1 : 9;
    AtUnitCtx c; c.qt = qt; c.nitems = qt + 1 + nwin; c.iq = iq; c.l31 = l31; c.hi = hi; c.tid = tid; c.w = w; c.vp0 = vp0; c.kvb = kvb; c.koff_kv = koff_kv; c.voff_kv = voff_kv;
    at_dma_tile(ring, 2, w, kc, vc, koff_c, voff_c);
    if (two_cmp) at_dma_tile(ring, 3, w, kc + 8192, vc + 8192, koff_c, voff_c);
    at_dma_tile(ring, 0, w, kvb + 512, kvb + 768, koff_kv, voff_kv);
    { int n1; bool w1; at_item(c, 1, n1, w1); const GAS unsigned char* tb = kvb + (size_t)n1 * 98304 + (w1 ? 1024 : 512); at_dma_tile(ring, 1, w, tb, tb + 256, koff_kv, voff_kv); }
#pragma unroll
    for (int ks = 0; ks < 4; ++ks) *(LAS v4u*)(qp + ks * 1024) = *(const GAS v4u*)(Q + row * 512 + (g * 4 + head) * 64 + 16 * ks + 8 * hi);
    float gate[3];
#pragma unroll
    for (int br = 0; br < 3; ++br) gate[br] = sigmoidf_(NG[row * 24 + br * 8 + g * 4 + head]);
    asm volatile("" : "+v"(gate[0]), "+v"(gate[1]), "+v"(gate[2]));
    c.gate1 = gate[1]; c.gate2 = gate[2];
    AT_WAIT_BAR(0);
    {
        const int cmax = (t >= 31) ? ((t - 31) >> 4) : -1; const int cadj = cmax - 4 * hi;
        f32x16 s0[2], s1[2];
        at_qk(ring + AT_KRING + 2 * AT_SLOT, qp, l31, hi, s0);
        if (two_cmp) at_qk(ring + AT_KRING + 3 * AT_SLOT, qp, l31, hi, s1);
        else {
#pragma unroll
            for (int kh = 0; kh < 2; ++kh)
#pragma unroll
                for (int i = 0; i < 16; ++i) s1[kh][i] = -INFINITY;
        }
        float mx = -INFINITY;
#pragma unroll
        for (int kh = 0; kh < 2; ++kh)
#pragma unroll
            for (int i = 0; i < 16; ++i) {
                const int c0 = 32 * kh + crow16(i, 0);
                s0[kh][i] = (c0 <= cadj) ? s0[kh][i] : -INFINITY; s1[kh][i] = (64 + c0 <= cadj) ? s1[kh][i] : -INFINITY;
                mx = fmaxf(mx, fmaxf(s0[kh][i], s1[kh][i]));
            }
        mx = xhalf_max(mx);
        const float msafe = (mx == -INFINITY) ? 0.f : mx;
        float sum = 0.f;
#pragma unroll
        for (int kh = 0; kh < 2; ++kh)
#pragma unroll
            for (int i = 0; i < 16; ++i) { const float e0 = fast_exp2(s0[kh][i] - msafe), e1 = fast_exp2(s1[kh][i] - msafe); s0[kh][i] = e0; s1[kh][i] = e1; sum += e0 + e1; }
        sum = xhalf_sum(sum);
        const float inv = (sum > 0.f) ? 1.0f / sum : 0.f;
#pragma unroll
        for (int kh = 0; kh < 2; ++kh)
#pragma unroll
            for (int i = 0; i < 16; ++i) { s0[kh][i] *= inv; s1[kh][i] *= inv; }
        float G[16], L[16];
#pragma unroll
        for (int kh = 0; kh < 2; ++kh)
#pragma unroll
            for (int rq = 0; rq < 4; ++rq) {
                G[4 * kh + rq] = (s0[kh][4 * rq] + s0[kh][4 * rq + 1]) + (s0[kh][4 * rq + 2] + s0[kh][4 * rq + 3]); L[4 * kh + rq] = s0[kh][4 * rq + 3];
                G[8 + 4 * kh + rq] = (s1[kh][4 * rq] + s1[kh][4 * rq + 1]) + (s1[kh][4 * rq + 2] + s1[kh][4 * rq + 3]); L[8 + 4 * kh + rq] = s1[kh][4 * rq + 3];
            }
        {
            f32x16 oc[2];
#pragma unroll
            for (int dh = 0; dh < 2; ++dh)
#pragma unroll
                for (int i = 0; i < 16; ++i) oc[dh][i] = 0.f;
            bf16x8_t pf[2][2];
            at_pack(s0, pf); at_pv(ring + AT_VRING + 2 * AT_SLOT, vp0, pf, oc);
            if (two_cmp) { at_pack(s1, pf); at_pv(ring + AT_VRING + 3 * AT_SLOT, vp0, pf, oc); }
#pragma unroll
            for (int dh = 0; dh < 2; ++dh)
#pragma unroll
                for (int pr = 0; pr < 8; ++pr) outw[(dh * 8 + pr) * 64 + lane] = pk2(gate[0] * oc[dh][2 * pr], gate[0] * oc[dh][2 * pr + 1]);
        }
        unsigned selmask;
        if (qt < 8) selmask = (2u << qt) - 1u;
        else {
#pragma unroll
            for (int i = 0; i < 16; ++i) { G[i] += dpp_xor1(G[i]); G[i] += dpp_xor2(G[i]); L[i] += dpp_xor1(L[i]); L[i] += dpp_xor2(L[i]); }
#pragma unroll
            for (int i = 0; i < 16; ++i) L[i] = xhalf(L[i]);
#pragma unroll
            for (int i = 15; i >= 0; --i) { const float prev = (i > 0) ? L[i - 1] : 0.f; G[i] = G[i] + (hi ? L[i] : prev); }
            {
                const int nlim = qt - 1, hq = l31 & 3;
                const float a0 = (hq & 1) ? G[4] : G[0], a1 = (hq & 1) ? G[5] : G[1], a2 = (hq & 1) ? G[6] : G[2], a3 = (hq & 1) ? G[7] : G[3];
                const float b0 = (hq & 1) ? G[12] : G[8], b1 = (hq & 1) ? G[13] : G[9], b2 = (hq & 1) ? G[14] : G[10], b3 = (hq & 1) ? G[15] : G[11];
                const int n0 = 8 * hq + hi, n1 = n0 + 2, n2 = n0 + 4, n3 = n0 + 6;
                float c0 = (hq & 2) ? b0 : a0, c1 = (hq & 2) ? b1 : a1, c2 = (hq & 2) ? b2 : a2, c3 = (hq & 2) ? b3 : a3;
                c0 = (n0 >= 1 && n0 < nlim) ? c0 : -INFINITY; c1 = (n1 < nlim) ? c1 : -INFINITY; c2 = (n2 < nlim) ? c2 : -INFINITY; c3 = (n3 < nlim) ? c3 : -INFINITY;
                selmask = 1u | (1u << qt) | (1u << (qt - 1));
#pragma unroll
                for (int k = 0; k < 5; ++k) {
                    float bv = fmaxf(fmaxf(c0, c1), fmaxf(c2, c3));
                    bv = fmaxf(bv, dpp_xor1(bv)); bv = fmaxf(bv, dpp_xor2(bv)); bv = xhalf_max(bv);
                    const bool fin = bv > -INFINITY;
                    int li = 99;
                    li = (c3 == bv && fin) ? n3 : li; li = (c2 == bv && fin) ? n2 : li; li = (c1 == bv && fin) ? n1 : li; li = (c0 == bv && fin) ? n0 : li;
                    { const int o1 = __float_as_int(dpp_xor1(__int_as_float(li))); li = (o1 < li) ? o1 : li; }
                    { const int o2 = __float_as_int(dpp_xor2(__int_as_float(li))); li = (o2 < li) ? o2 : li; }
                    { const int o3 = __float_as_int(xhalf(__int_as_float(li))); li = (o3 < li) ? o3 : li; }
                    selmask |= (li < 32) ? (1u << li) : 0u;
                    c0 = (n0 == li) ? -INFINITY : c0; c1 = (n1 == li) ? -INFINITY : c1; c2 = (n2 == li) ? -INFINITY : c2; c3 = (n3 == li) ? -INFINITY : c3;
                }
            }
        }
        c.selmask = selmask;
    }
    asm volatile("s_waitcnt lgkmcnt(0)\n\ts_barrier" ::: "memory");
    if (c.nitems > 2) { int n2; bool w2; at_item(c, 2, n2, w2); const GAS unsigned char* tb = kvb + (size_t)n2 * 98304 + (w2 ? 1024 : 512); at_dma_tile(ring, 2, w, tb, tb + 256, koff_kv, voff_kv);
        AT_WAIT_BAR(2); }
    else AT_WAIT_BAR(0);
    float m = -INFINITY, l = 0.f, mq = 0.f;
    f32x16 negm;
#pragma unroll
    for (int i = 0; i < 16; ++i) negm[i] = 0.f;
    f32x16 o[2], sa[2], sb[2];
#pragma unroll
    for (int dh = 0; dh < 2; ++dh)
#pragma unroll
        for (int i = 0; i < 16; ++i) o[dh][i] = 0.f;
    at_qk(ring + AT_KRING, qp, l31, hi, sa);
    for (int it = 0; it < c.nitems; it += 2) {
        at_step(c, ring, outw, it, 0, qp, sa, sb, m, l, o, lane, negm, mq);
        if (it + 1 < c.nitems) at_step(c, ring, outw, it + 1, 0, qp, sb, sa, m, l, o, lane, negm, mq);
    }
    GAS bf16* dst = AO + row * 1024 + (g * 4 + head) * 64;
#pragma unroll
    for (int dh = 0; dh < 2; ++dh)
#pragma unroll
        for (int k2 = 0; k2 < 2; ++k2) {
            const int rq = hi + 2 * k2;
            const LAS unsigned* p = outw + (dh * 8 + 2 * rq) * 64 + l31;
            v4u wv; wv.x = p[0]; wv.y = p[64]; wv.z = p[32]; wv.w = p[96];
            *(GAS v4u*)(dst + 32 * dh + 8 * rq) = wv;
        }
}
__device__ __forceinline__ void attn_mfma_phase(Frame& F, const GAS bf16* Q, const GAS bf16* KV, const GAS bf16* KCMP, const GAS bf16* VCMP, const GAS float* NG, GAS bf16* AO  ) {
    int task = F.rk;
#pragma unroll 1
    for (; task < F.nb * 16; task += F.nl) {
        const int slot = task & 7, g = (task >> 3) & 1, b = F.b0 + (task >> 4);
        const unsigned pk = slot == 0 ? 45883u : slot == 1 ? 245269u : slot == 2 ? 10079u : slot == 3 ? 172606u : slot == 4 ? 77469u : slot == 5 ? 211542u : slot == 6 ? 142072u : 112252u;
#pragma unroll 1
        for (int k = 0; k < 4; ++k) attn_unit(F, b, g, (int)((pk >> (5 * k)) & 31u), Q + (size_t)b * XE_Q, KV, KCMP, VCMP, NG, AO);
    }
    __syncthreads();
}

#ifndef MK_SINGLE
#define MK_SINGLE 1
#endif
constexpr int NPL = 10, NPHASES = 2 + DEPTH * NPL;
struct Args { const float* in[22]; float* out; unsigned char* ws; int ph_lo, ph_hi; };
__global__ void __launch_bounds__(NWAVES * 64, 2) fwd(Args args) {
    extern __shared__ __attribute__((aligned(16))) unsigned char lds[];
    Frame F0;
    F0.lds = (LAS unsigned char*)lds;
    F0.tid = threadIdx.x; F0.lane = F0.tid & 63; F0.wave = __builtin_amdgcn_readfirstlane(F0.tid >> 6);
    F0.G = gridDim.x; { const int bx = blockIdx.x; F0.vcu = (F0.G % 8 == 0) ? (bx % 8) * (F0.G / 8) + bx / 8 : bx; }
    F0.out = (GAS float*)args.out; F0.ws = (GAS unsigned char*)args.ws;
    for (int u = F0.tid; u < (LDS_BYTES - LDSCTL_OFF) / 4; u += NWAVES * 64) ((LAS unsigned*)(F0.lds + LDSCTL_OFF))[u] = 0u;
    __syncthreads();
    if (F0.tid < 22) ((LAS unsigned long long*)(F0.lds + PTR_OFF))[F0.tid] = (unsigned long long)args.in[F0.tid];
    __syncthreads();
#if MK_SINGLE
    constexpr int lo = 0, hi = NPHASES;
#else
    const int lo = args.ph_lo, hi = args.ph_hi;
#endif
    XcdBarrier bar; bar.bar = (GAS unsigned*)(F0.ws + WS_CTL) + CW_BAR; bar.x = 0; bar.st = nullptr;
    if (hi - lo > 1) bar = xcd_barrier_post((GAS unsigned*)(F0.ws + WS_CTL) + CW_BAR, (volatile LAS unsigned*)(F0.lds + MISC_OFF) + 8, F0.tid);
#define IN(k) (lo <= (k) && (k) < hi)
#define SEAM(k) do { if (IN((k) + 1)) { if ((k) == 0) xcd_barrier(bar, F0.wave); else dom_barrier(bar, F0.wave); } } while (0)

    if (IN(0)) { Frame F = F0; asm volatile("" : "+s"(F.wave), "+s"(F.vcu)); { unsigned ones_ = ~0u; asm volatile("" : "+s"(ones_)); F.lane = (int)__builtin_amdgcn_mbcnt_hi(ones_, __builtin_amdgcn_mbcnt_lo(ones_, 0u)); } F.tid = (F.wave << 6) | F.lane; asm volatile("" : "+v"(F.tid), "+v"(F.lane)); p0_prologue(F);
#if defined(REP_PHASE) && REP_PHASE == 100
        __syncthreads(); p0_prologue(F);
#endif
        SEAM(0); }

#define OPQ() Frame F = F0; asm volatile("" : "+s"(F.wave), "+s"(F.vcu)); { unsigned ones_ = ~0u; asm volatile("" : "+s"(ones_)); F.lane = (int)__builtin_amdgcn_mbcnt_hi(ones_, __builtin_amdgcn_mbcnt_lo(ones_, 0u)); } F.tid = (F.wave << 6) | F.lane; asm volatile("" : "+v"(F.tid), "+v"(F.lane)); GAS unsigned char* ws = F.ws; GAS float* XR = F.out; asm volatile("" : "+s"(ws), "+s"(XR)); dom_load(F); \
    GAS bf16* H = (GAS bf16*)(ws + WS_H); GAS bf16* ZC = (GAS bf16*)(ws + WS_ZC); GAS bf16* Qb = (GAS bf16*)(ws + WS_Q); GAS bf16* KV = (GAS bf16*)(ws + WS_KV); GAS bf16* MG = (GAS bf16*)(ws + WS_MG); \
    GAS float* NG = (GAS float*)(ws + WS_NG); GAS bf16* KCMP = (GAS bf16*)(ws + WS_KCMP); GAS bf16* VCMP = (GAS bf16*)(ws + WS_VCMP); GAS bf16* CVAO = (GAS bf16*)(ws + WS_CVAO); GAS bf16* U = (GAS bf16*)(ws + WS_U); GAS bf16* A1 = (GAS bf16*)(ws + WS_A1); \
    const GAS float* cond_l = (const GAS float*)(ws + WS_COND) + (size_t)l * BATCH * NCOND; GAS unsigned char* wl = ws + WS_W + (size_t)l * W_LAYER; \
    (void)H; (void)ZC; (void)Qb; (void)KV; (void)MG; (void)NG; (void)KCMP; (void)VCMP; (void)CVAO; (void)U; (void)A1; (void)cond_l; (void)wl; (void)XR
    for (int l = 0; l < DEPTH; ++l) {
        const int pb = 1 + l * NPL;
        if (!(lo < pb + NPL && pb < hi)) continue;
        if (IN(pb + 0)) { OPQ(); const GAS float* x32 = (l == 0) ? INP(F, 0) : (const GAS float*)0; norm_mod_phase(F, x32, (const GAS bf16*)XR, INP(F, 5) + (size_t)l * DM, cond_l, 0, 1, H);
#if defined(REP_PHASE) && REP_PHASE == 0
            norm_mod_phase(F, x32, (const GAS bf16*)XR, INP(F, 5) + (size_t)l * DM, cond_l, 0, 1, H);
#endif
            SEAM(pb + 0); }
        if (IN(pb + 1)) { OPQ();
            pg8::Gemm g{H, (const GAS bf16*)(wl + W_IN), MROWS, NPAD, DM, DM, DM}; pg8::StaticOrder S; S.init(F.nb * (SEQ / 256), NPAD, F.nl, F.rk, F.b0 * (SEQ / 256));
            pg8::EpiIn E{ws, (const GAS float*)(ws + WS_BINP) + (size_t)l * NPAD};
            pg8::gemm_phase<pg8::EpiIn, pg8::StaticOrder, true, true>(F.lds, g, S, E, F.wave);
#if defined(REP_PHASE) && REP_PHASE == 1
            __syncthreads(); pg8::gemm_phase<pg8::EpiIn, pg8::StaticOrder, true, true>(F.lds, g, S, E, F.wave);
#endif
            SEAM(pb + 1);
        }
        if (IN(pb + 2)) { OPQ();
#ifdef CMP_NAIVE
            static_assert(false, "CMP_NAIVE is not supported in the domain build");
#else
            const int ncmp = 4 * F.nb;
#pragma unroll 1
            for (int cu = F.rk; cu < ncmp; cu += F.nl) {
                const int kh = cu & 1, kind = (cu >> 1) & 1, cb = F.b0 + (cu >> 2);
                GAS unsigned char* cw = ws + WS_CW;
                GAS unsigned* flag = (GAS unsigned*)(ws + WS_CTL) + 8192 + ((l * BATCH + cb) * 2 + kind) * 16;
                GAS unsigned char* part = (GAS unsigned char*)XR + ((size_t)cb * SEQ + kind * 256) * 4096 + 2048;
                const GAS bf16* W1 = (const GAS bf16*)(cw + CW_W1T) + (size_t)(l * 2 + kind) * 256 * 2048 + kh * (14 * 64);
                pg8::Gemm g{KV + kind * 128 + kh * 14 * 768, W1, 4096, 256, kh ? 18 * 64 : 14 * 64, 16 * 768, 2048, (size_t)1536, (size_t)128, (size_t)SEQ * 768 * 2};
                if (kh == 0) {
                    pg8::OneUnitSig S{true, cb, flag};
                    pg8::EpiCmpPart E{part};
                    pg8::gemm_phase<pg8::EpiCmpPart, pg8::OneUnitSig, false, true>(F.lds, g, S, E, F.wave);
                } else {
                    pg8::OneUnit S{true, cb};
                    pg8::EpiCmp E{(const GAS float*)(cw + CW_B1) + (l * 2 + kind) * 8 * 256, (const GAS bf16*)(cw + CW_W2T) + (size_t)(l * 2 + kind) * 64 * 256, kind ? VCMP : KCMP, part, flag};
                    pg8::gemm_phase<pg8::EpiCmp, pg8::OneUnit, false, true>(F.lds, g, S, E, F.wave);
                }
                __syncthreads();
            }
            if (F.nl > ncmp) { if (F.rk >= ncmp) conv_phase(F, ZC, INP(F, 8) + (size_t)l * 3 * 512, CVAO, F.rk - ncmp, F.nl - ncmp); }
            else conv_phase(F, ZC, INP(F, 8) + (size_t)l * 3 * 512, CVAO, F.rk, F.nl);
#endif
            SEAM(pb + 2); }
        if (IN(pb + 3)) { OPQ();
#ifdef ATTN_NAIVE
            attn_naive_phase(F, Qb, KV, KCMP, VCMP, NG, CVAO + 512); __syncthreads();
#else
            attn_mfma_phase(F, Qb, KV, KCMP, VCMP, NG, CVAO + 512);
#if defined(REP_PHASE) && REP_PHASE == 3
            attn_mfma_phase(F, Qb, KV, KCMP, VCMP, NG, CVAO + 512);
#endif
#endif
            SEAM(pb + 3); }
        if (IN(pb + 4)) { OPQ();
            pg8::Gemm g{CVAO, (const GAS bf16*)(wl + W_UP), MROWS, DM, DM, DM, DM}; pg8::StaticOrder S; S.init(F.nb * (SEQ / 256), DM, F.nl, F.rk, F.b0 * (SEQ / 256));
            pg8::EpiUpM E{U, MG};
            pg8::gemm_phase<pg8::EpiUpM, pg8::StaticOrder, true, true>(F.lds, g, S, E, F.wave);
            SEAM(pb + 5);
        }
        if (IN(pb + 6)) { OPQ(); const GAS float* xin = (l == 0) ? INP(F, 0) : (const GAS float*)0;
            pg8::Gemm g{U, (const GAS bf16*)(wl + W_O), MROWS, DM, DM, DM, DM, 0, 0, 0, XE_U * 2}; pg8::StaticOrder S; S.init(F.nb * (SEQ / 256), DM, F.nl, F.rk, F.b0 * (SEQ / 256));
            pg8::EpiRes E{xin, (GAS bf16*)XR, cond_l + 2 * DM};
            pg8::gemm_phase<pg8::EpiRes, pg8::StaticOrder, true, true>(F.lds, g, S, E, F.wave);
            SEAM(pb + 6);
        }
        if (IN(pb + 7)) { OPQ(); norm_mod_phase(F, (const GAS float*)0, (const GAS bf16*)XR, INP(F, 18) + (size_t)l * DM, cond_l, 3, 4, H);
#if defined(REP_PHASE) && REP_PHASE == 0
            norm_mod_phase(F, (const GAS float*)0, (const GAS bf16*)XR, INP(F, 18) + (size_t)l * DM, cond_l, 3, 4, H);
#endif
            SEAM(pb + 7); }
        if (IN(pb + 8)) { OPQ();
            pg8::Gemm g{H, (const GAS bf16*)(wl + W_F1), MROWS, DFF, DM, DM, DM}; pg8::StaticOrder S; S.init(F.nb * (SEQ / 256), DFF, F.nl, F.rk, F.b0 * (SEQ / 256));
            pg8::EpiFf1 E{A1};
            pg8::gemm_phase<pg8::EpiFf1, pg8::StaticOrder, true, true>(F.lds, g, S, E, F.wave);
            SEAM(pb + 8);
        }
        if (IN(pb + 9)) { OPQ();
            pg8::Gemm g{A1, (const GAS bf16*)(wl + W_F2), MROWS, DM, DFF, DFF, DFF}; pg8::StaticOrder S; S.init(F.nb * (SEQ / 256), DM, F.nl, F.rk, F.b0 * (SEQ / 256));
            pg8::EpiRes E{(const GAS float*)0, (GAS bf16*)XR, cond_l + 5 * DM};
            pg8::gemm_phase<pg8::EpiRes, pg8::StaticOrder, true, true>(F.lds, g, S, E, F.wave);
            SEAM(pb + 9);
        }
    }
    if (IN(NPHASES - 1)) { Frame F = F0; asm volatile("" : "+s"(F.wave), "+s"(F.vcu)); { unsigned ones_ = ~0u; asm volatile("" : "+s"(ones_)); F.lane = (int)__builtin_amdgcn_mbcnt_hi(ones_, __builtin_amdgcn_mbcnt_lo(ones_, 0u)); } F.tid = (F.wave << 6) | F.lane; asm volatile("" : "+v"(F.tid), "+v"(F.lane)); dom_load(F); final_norm_phase(F, (const GAS bf16*)F.out, INP(F, 21), F.out); }
#undef IN
#undef SEAM
}


#ifdef PROBE_N
__global__ void dump_k(const unsigned char* ws, float* out, int mode) {
    const size_t n = (size_t)MROWS * DM;
    for (size_t i = (size_t)blockIdx.x * blockDim.x + threadIdx.x; i < n; i += (size_t)gridDim.x * blockDim.x) {
        float v = 0.f;
        if (mode == 0) { v = bf2f(((const bf16*)(ws + WS_ZC))[i]) + bf2f(((const bf16*)(ws + WS_MG))[i]) + bf2f(((const bf16*)(ws + WS_Q))[i % ((size_t)MROWS * 512)]) + bf2f(((const bf16*)(ws + WS_KV))[i % ((size_t)MROWS * 768)]) + ((const float*)(ws + WS_NG))[i % ((size_t)MROWS * 24)]; }
        else if (mode == 1) { v = bf2f(((const bf16*)(ws + WS_CVAO))[i]) + bf2f(((const bf16*)(ws + WS_KCMP))[i % (size_t)(BATCH * 2 * 128 * 64)]) + bf2f(((const bf16*)(ws + WS_VCMP))[i % (size_t)(BATCH * 2 * 128 * 64)]); }
        else if (mode == 2) { v = bf2f(((const bf16*)(ws + WS_U))[i]); }
        else if (mode == 3) { v = out[i]; }
        else if (mode == 4) { v = bf2f(((const bf16*)(ws + WS_H))[i]); }
        else if (mode == 5) { v = bf2f(((const bf16*)(ws + WS_A1))[i]) + bf2f(((const bf16*)(ws + WS_A1))[i + n]) + bf2f(((const bf16*)(ws + WS_A1))[i + 2 * n]) + bf2f(((const bf16*)(ws + WS_A1))[i + 3 * n]); }
        out[i] = v;
    }
}
#endif
extern "C" void kernel_launch(void* const* d_in, const int* in_sizes, int n_in, void* d_out, int out_size, void* d_ws, size_t ws_size, hipStream_t stream) {
    static int grid = 0;
    if (grid == 0) {
        if (n_in != 22 || out_size != MROWS * DM || ws_size < WS_END) { fprintf(stderr, "kernel_launch: unexpected shapes (n_in %d out %d ws %zu need %zu)\n", n_in, out_size, ws_size, (size_t)WS_END); grid = -1; return; }
        int dev = 0, cus = 0, per_cu = 0;
        if (hipGetDevice(&dev) != hipSuccess || hipDeviceGetAttribute(&cus, hipDeviceAttributeMultiprocessorCount, dev) != hipSuccess) { grid = -1; return; }
        if (hipFuncSetAttribute((const void*)fwd, hipFuncAttributeMaxDynamicSharedMemorySize, LDS_BYTES) != hipSuccess) { fprintf(stderr, "kernel_launch: hipFuncSetAttribute failed\n"); grid = -1; return; }
        if (hipOccupancyMaxActiveBlocksPerMultiprocessor(&per_cu, (const void*)fwd, NWAVES * 64, LDS_BYTES) != hipSuccess || per_cu < 1)
            fprintf(stderr, "kernel_launch: occupancy query reports %d workgroups per CU\n", per_cu);
        (void)hipGetLastError();
        grid = cus;
    }
    if (grid < 0) return;
    if (hipMemsetAsync((char*)d_ws + WS_CTL, 0, CTL_ZERO_BYTES, stream) != hipSuccess) return;
    Args a{};
    for (int i = 0; i < 22; ++i) a.in[i] = (const float*)d_in[i];
    a.out = (float*)d_out; a.ws = (unsigned char*)d_ws;
#if MK_SINGLE
    a.ph_lo = 0; a.ph_hi = NPHASES;
    hipLaunchKernelGGL(fwd, dim3(grid), dim3(NWAVES * 64), LDS_BYTES, stream, a);
#else
#ifdef PROBE_N
    for (int p = 0; p < PROBE_N; ++p) { a.ph_lo = p; a.ph_hi = p + 1; hipLaunchKernelGGL(fwd, dim3(grid), dim3(NWAVES * 64), LDS_BYTES, stream, a); }
    hipLaunchKernelGGL(dump_k, dim3(2048), dim3(256), 0, stream, (const unsigned char*)d_ws, (float*)d_out, PROBE_MODE);
#else
    for (int p = 0; p < NPHASES; ++p) { a.ph_lo = p; a.ph_hi = p + 1; hipLaunchKernelGGL(fwd, dim3(grid), dim3(NWAVES * 64), LDS_BYTES, stream, a); }
#endif
#endif
}
```

```cpp
#include <hip/hip_runtime.h>
#include <cstdio>
#include <cstdint>
namespace pg8 {
#define PG8_LAS __attribute__((address_space(3)))
typedef unsigned short bf16_t;
typedef short bf16x8 __attribute__((ext_vector_type(8)));
typedef float f32x4 __attribute__((ext_vector_type(4)));
typedef unsigned u32x4 __attribute__((ext_vector_type(4)));
constexpr int BM = 256, BK = 64, HALF = 128, HTB = HALF * BK * 2  , STAGE_BYTES = 8 * HTB, NXCD = 8, WGM = 4;

__host__ __device__ __forceinline__ int lds_byte(int r, int c) { const int st = (r >> 4) * 2 + (c >> 5), rr = r & 15, cc = c & 31, ob = rr * 64 + cc * 2; return st * 1024 + (ob ^ (((ob >> 9) & 1) << 5)); }
__host__ __device__ __forceinline__ void stage_rc(int b, int& R, int& C) { const int st = b / 1024, sb = b % 1024, swz = sb ^ (((sb >> 9) & 1) << 5); R = (st >> 1) * 16 + swz / 64; C = (st & 1) * 32 + (swz % 64) / 2; }
__host__ __device__ __forceinline__ int perm32(int rho) { const int n = rho >> 4, i = rho & 15; return 8 * (i >> 2) + 4 * n + (i & 3); }

struct Unit { int pm, pn; };
struct Gemm { const __attribute__((address_space(1))) bf16_t* A; const __attribute__((address_space(1))) bf16_t* Bt; int M, N, K, lda, ldb; size_t a_kstep = 0, a_hstep = 0, a_tstep = 0, a_bextra = 0; };

struct StaticOrder {
    int nM, nN, nwg, G, c, pm0;
    __host__ __device__ void init(int nM_, int N, int G_, int c_, int pm0_) { nM = nM_; nN = N / BM; nwg = nM * nN; G = G_; c = c_; pm0 = pm0_; }
    __host__ __device__ bool next(int i, Unit& u) const {
        const long L = (long)i * G + c; if (L >= nwg) return false;
        const int wgid = (int)L;
        const int nig = WGM * nN, gid = wgid / nig, fm = gid * WGM, gsz = (nM - fm) < WGM ? (nM - fm) : WGM;
        u.pm = pm0 + fm + ((wgid % nig) % gsz); u.pn = (wgid % nig) / gsz; return true;
    }
    __device__ __forceinline__ void a_ready(const Unit&) const {}
    __device__ __forceinline__ void done(const Unit&) const {}
};

typedef float cvt_f2 __attribute__((ext_vector_type(2)));
typedef __bf16 cvt_b2 __attribute__((ext_vector_type(2)));
__device__ __forceinline__ unsigned cvt_pk_bf16(float lo, float hi) { const cvt_f2 v = {lo, hi}; const cvt_b2 r = __builtin_convertvector(v, cvt_b2); return __builtin_bit_cast(unsigned, r); }
template <class Epi, class Sched, bool ALIGN_EPI = false, bool SP2 = false>
__device__ __forceinline__ void gemm_phase(PG8_LAS unsigned char* lds, const Gemm g, const Sched& S, const Epi& E, int wave_in) {
    unsigned ones_ = ~0u; asm volatile("" : "+s"(ones_));
    int tid_ = (wave_in << 6) | (int)__builtin_amdgcn_mbcnt_hi(ones_, __builtin_amdgcn_mbcnt_lo(ones_, 0u)); asm volatile("" : "+v"(tid_));
    const int tid = tid_, wid = __builtin_amdgcn_readfirstlane(tid >> 6), lane = tid & 63, wr = wid >> 2, wc = wid & 3, fr = lane & 15, fq = lane >> 4;
    const int K = g.K, nt = K / BK;
    unsigned voffA[2], voffB[2];
#pragma unroll
    for (int i = 0; i < 2; ++i) { int R, C; stage_rc(tid * 16 + i * 8192, R, C); const int Rb = Epi::PERM ? ((R & ~31) + perm32(R & 31)) : R;
        voffA[i] = (unsigned)(R * g.lda + C) * 2u; voffB[i] = (unsigned)(Rb * g.ldb + C) * 2u; }
    const size_t kstepB = (size_t)(BK * 2), kstepA = g.a_kstep ? g.a_kstep : kstepB;
    const size_t hstepA = g.a_hstep ? g.a_hstep : (size_t)HALF * g.lda * 2, hstepB = (size_t)HALF * g.ldb * 2;
    const size_t tstepA = g.a_tstep ? g.a_tstep : 2 * hstepA, tstepB = 2 * hstepB;
    const unsigned ldsw = (unsigned)wid * 1024u;
    const int aoff = lds_byte(wr * 64 + fr, fq * 8), boff = lds_byte(wc * 32 + fr, fq * 8);
#define PG8_SA(b, h) (((b) * 2 + (h)) * HTB)
#define PG8_SB(b, h) ((4 + (b) * 2 + (h)) * HTB)
#define PG8_STAGE(bufoff, gbase, voff) do { _Pragma("unroll") for (int _i = 0; _i < 2; ++_i) \
        __builtin_amdgcn_global_load_lds((const unsigned*)((const char*)(gbase) + (voff)[_i]), (PG8_LAS unsigned*)(lds + (bufoff) + ldsw + _i * 8192), 16, 0, 0); } while (0)
#define PG8_LDA(dst, b, h) do { _Pragma("unroll") for (int m = 0; m < 4; ++m) _Pragma("unroll") for (int k = 0; k < 2; ++k) dst[m][k] = *(const PG8_LAS bf16x8*)(lds + PG8_SA(b, h) + aoff + m * 2048 + k * 1024); } while (0)
#define PG8_LDB(dst, b, h) do { _Pragma("unroll") for (int n = 0; n < 2; ++n) _Pragma("unroll") for (int k = 0; k < 2; ++k) dst[n][k] = *(const PG8_LAS bf16x8*)(lds + PG8_SB(b, h) + boff + n * 2048 + k * 1024); } while (0)
#define PG8_MMA(ai, bj, At, Bt) do { __builtin_amdgcn_s_setprio(1); _Pragma("unroll") for (int m = 0; m < 4; ++m) _Pragma("unroll") for (int n = 0; n < 2; ++n) _Pragma("unroll") for (int k = 0; k < 2; ++k) \
        acc[ai][bj][m][n] = __builtin_amdgcn_mfma_f32_16x16x32_bf16(Bt[n][k], At[m][k], acc[ai][bj][m][n], 0, 0, 0); __builtin_amdgcn_s_setprio(0); } while (0)
#define PG8_WAIT_V(n) asm volatile("s_waitcnt vmcnt(" #n ")" ::: "memory")
#define PG8_WAIT_L(n) asm volatile("s_waitcnt lgkmcnt(" #n ")" ::: "memory")
#define PG8_BAR __builtin_amdgcn_s_barrier()
#define PG8_SCHED __builtin_amdgcn_sched_barrier(0)
    Unit cur, nxt; int ui = 0;
    if (!S.next(0, cur)) return;
    f32x4 acc[2][2][4][2];
#pragma unroll
    for (int a = 0; a < 2; ++a)
#pragma unroll
        for (int b = 0; b < 2; ++b)
#pragma unroll
            for (int m = 0; m < 4; ++m)
#pragma unroll
                for (int n = 0; n < 2; ++n) acc[a][b][m][n] = (f32x4){0.f, 0.f, 0.f, 0.f};
    bf16x8 At[4][2], B0[2][2], B1[2][2];
    const char* cA = (const char*)g.A + (size_t)cur.pm * tstepA + (size_t)(cur.pm >> 3) * g.a_bextra; const char* cB = (const char*)g.Bt + (size_t)cur.pn * tstepB;
    S.a_ready(cur);
    if constexpr (SP2) {
        PG8_STAGE(PG8_SB(0, 0), cB, voffB); PG8_STAGE(PG8_SB(0, 1), cB + hstepB, voffB); PG8_STAGE(PG8_SA(0, 0), cA, voffA); PG8_STAGE(PG8_SA(0, 1), cA + hstepA, voffA);
        if (wr == 1) PG8_BAR;
        PG8_WAIT_V(2); PG8_BAR;
        PG8_STAGE(PG8_SB(1, 0), cB + kstepB, voffB); PG8_STAGE(PG8_SA(1, 0), cA + kstepA, voffA); PG8_STAGE(PG8_SB(1, 1), cB + hstepB + kstepB, voffB);
        PG8_WAIT_V(6); PG8_BAR;
    } else {
        PG8_STAGE(PG8_SB(0, 0), cB, voffB); PG8_STAGE(PG8_SA(0, 0), cA, voffA); PG8_STAGE(PG8_SB(0, 1), cB + hstepB, voffB); PG8_STAGE(PG8_SA(0, 1), cA + hstepA, voffA);
        if (wr == 1) PG8_BAR;
        PG8_WAIT_V(4); PG8_BAR;
        PG8_STAGE(PG8_SB(1, 0), cB + kstepB, voffB); PG8_STAGE(PG8_SA(1, 0), cA + kstepA, voffA); PG8_STAGE(PG8_SB(1, 1), cB + hstepB + kstepB, voffB);
        PG8_WAIT_V(6); PG8_BAR;
    }
    for (;;) {
        const bool has_next = S.next(ui + 1, nxt);
        const char* nA = has_next ? (const char*)g.A + (size_t)nxt.pm * tstepA + (size_t)(nxt.pm >> 3) * g.a_bextra : cA; const char* nB = has_next ? (const char*)g.Bt + (size_t)nxt.pn * tstepB : cB;
        for (int t = 0; t < nt; t += 2) {
            const bool last = (t == nt - 2);
            const char* a1 = cA + (size_t)(t + 1) * kstepA;
            const char* a2 = last ? nA : cA + (size_t)(t + 2) * kstepA; const char* b2 = last ? nB : cB + (size_t)(t + 2) * kstepB;
            const char* a3 = a2 + kstepA; const char* b3 = b2 + kstepB;
            if (last && has_next) S.a_ready(nxt);
            if constexpr (Epi::MID_T > 0) { if (t == Epi::MID_T) { Unit mu = cur; unsigned mo_ = ~0u; asm volatile("" : "+s"(mo_)); const int ml_ = (int)__builtin_amdgcn_mbcnt_hi(mo_, __builtin_amdgcn_mbcnt_lo(mo_, 0u)); int mfr = ml_ & 15, mfq = ml_ >> 4; asm volatile("" : "+s"(mu.pm), "+s"(mu.pn), "+v"(mfr), "+v"(mfq)); E.mid(acc, mu, wr, wc, mfr, mfq); } }
            if constexpr (SP2) {
            PG8_LDB(B0, 0, 0); PG8_LDB(B1, 0, 1); PG8_SCHED; PG8_LDA(At, 0, 0); PG8_STAGE(PG8_SA(1, 1), a1 + hstepA, voffA);
            PG8_WAIT_V(8); PG8_WAIT_L(0); PG8_BAR; PG8_MMA(0, 0, At, B0); PG8_MMA(0, 1, At, B1); PG8_BAR; PG8_SCHED;
            PG8_LDA(At, 0, 1); PG8_STAGE(PG8_SB(0, 0), b2, voffB); PG8_STAGE(PG8_SB(0, 1), b2 + hstepB, voffB); PG8_STAGE(PG8_SA(0, 0), a2, voffA);
            PG8_WAIT_V(8); PG8_WAIT_L(0); PG8_BAR; PG8_MMA(1, 0, At, B0); PG8_MMA(1, 1, At, B1); PG8_BAR; PG8_SCHED;
            PG8_LDB(B0, 1, 0); PG8_LDB(B1, 1, 1); PG8_SCHED; PG8_LDA(At, 1, 0); PG8_STAGE(PG8_SA(0, 1), a2 + hstepA, voffA);
            PG8_WAIT_V(8); PG8_WAIT_L(0); PG8_BAR; PG8_MMA(0, 0, At, B0); PG8_MMA(0, 1, At, B1); PG8_BAR; PG8_SCHED;
            PG8_LDA(At, 1, 1); PG8_STAGE(PG8_SB(1, 0), b3, voffB); PG8_STAGE(PG8_SB(1, 1), b3 + hstepB, voffB); PG8_STAGE(PG8_SA(1, 0), a3, voffA);
            PG8_WAIT_V(8); PG8_WAIT_L(0); PG8_BAR; PG8_MMA(1, 0, At, B0); PG8_MMA(1, 1, At, B1); PG8_BAR; PG8_SCHED;
            } else {
            PG8_LDB(B0, 0, 0); PG8_SCHED; PG8_LDA(At, 0, 0); PG8_STAGE(PG8_SA(1, 1), a1 + hstepA, voffA);
            PG8_WAIT_L(8); PG8_BAR; PG8_WAIT_L(0); PG8_MMA(0, 0, At, B0); PG8_BAR; PG8_SCHED;
            PG8_LDB(B1, 0, 1); PG8_STAGE(PG8_SB(0, 0), b2, voffB);
            PG8_BAR; PG8_WAIT_L(0); PG8_MMA(0, 1, At, B1); PG8_BAR;
            PG8_LDA(At, 0, 1); PG8_STAGE(PG8_SA(0, 0), a2, voffA);
            PG8_BAR; PG8_WAIT_L(0); PG8_MMA(1, 0, At, B0); PG8_BAR; PG8_SCHED;
            PG8_STAGE(PG8_SB(0, 1), b2 + hstepB, voffB);
            PG8_WAIT_V(6); PG8_BAR; PG8_MMA(1, 1, At, B1); PG8_BAR;
            PG8_LDB(B0, 1, 0); PG8_SCHED; PG8_LDA(At, 1, 0); PG8_STAGE(PG8_SA(0, 1), a2 + hstepA, voffA);
            PG8_WAIT_L(8); PG8_BAR; PG8_WAIT_L(0); PG8_MMA(0, 0, At, B0); PG8_BAR; PG8_SCHED;
            PG8_LDB(B1, 1, 1); PG8_STAGE(PG8_SB(1, 0), b3, voffB);
            PG8_BAR; PG8_WAIT_L(0); PG8_MMA(0, 1, At, B1); PG8_BAR;
            PG8_LDA(At, 1, 1); PG8_STAGE(PG8_SA(1, 0), a3, voffA);
            PG8_BAR; PG8_WAIT_L(0); PG8_MMA(1, 0, At, B0); PG8_BAR; PG8_SCHED;
            PG8_STAGE(PG8_SB(1, 1), b3 + hstepB, voffB);
            PG8_WAIT_V(6); PG8_BAR; PG8_MMA(1, 1, At, B1); PG8_BAR;
            }
        }
        if constexpr (ALIGN_EPI) { if (wr == 0) PG8_BAR; }
        if constexpr (!Epi::AFTER_DRAIN) { Unit eu = cur; unsigned eo_ = ~0u; asm volatile("" : "+s"(eo_)); const int el_ = (int)__builtin_amdgcn_mbcnt_hi(eo_, __builtin_amdgcn_mbcnt_lo(eo_, 0u)); int efr = el_ & 15, efq = el_ >> 4; asm volatile("" : "+s"(eu.pm), "+s"(eu.pn), "+v"(efr), "+v"(efq));
            E(acc, eu, wr, wc, efr, efq); S.done(cur); }
        if (!has_next) break;
#pragma unroll
        for (int a = 0; a < 2; ++a)
#pragma unroll
            for (int b = 0; b < 2; ++b)
#pragma unroll
                for (int m = 0; m < 4; ++m)
#pragma unroll
                    for (int n = 0; n < 2; ++n) acc[a][b][m][n] = (f32x4){0.f, 0.f, 0.f, 0.f};
        cur = nxt; cA = nA; cB = nB; ++ui;
        if constexpr (ALIGN_EPI) { if (wr == 1) PG8_BAR; }
    }
    PG8_WAIT_V(0);
    if constexpr (!ALIGN_EPI) { if (wr == 0) PG8_BAR; }
    PG8_BAR;
    if constexpr (Epi::AFTER_DRAIN) { E.fused(acc, cur, wr, wc, fr, fq, lds, wid, lane); S.done(cur); }
#undef PG8_SA
#undef PG8_SB
#undef PG8_STAGE
#undef PG8_LDA
#undef PG8_LDB
#undef PG8_MMA
#undef PG8_WAIT_V
#undef PG8_WAIT_L
#undef PG8_BAR
#undef PG8_SCHED
}
}

constexpr int BATCH = 16, SEQ = 2048, DM = 1024, MROWS = BATCH * SEQ, DEPTH = 4;
constexpr int INW = 4888, NPAD = 5120, DFF = 4096, NCOND = 6 * DM;
constexpr int NCMP = 127;
constexpr float EPS = 1e-6f;
constexpr int XRP = 2048;
constexpr float C2 = 0.125f * 1.4426950408889634f;
#define GAS __attribute__((address_space(1)))
#define LAS __attribute__((address_space(3)))
typedef unsigned short bf16;
typedef unsigned v4u __attribute__((ext_vector_type(4)));
typedef unsigned v2u __attribute__((ext_vector_type(2)));
typedef float f32x4 __attribute__((ext_vector_type(4)));
__device__ __forceinline__ float bf_lo(unsigned u) { return __uint_as_float(u << 16); }
__device__ __forceinline__ float bf_hi(unsigned u) { return __uint_as_float(u & 0xffff0000u); }
__device__ __forceinline__ float bf2f(bf16 h) { return __uint_as_float(((unsigned)h) << 16); }
__device__ __forceinline__ unsigned pk2(float lo, float hi) { return pg8::cvt_pk_bf16(lo, hi); }
__device__ __forceinline__ float fast_exp2(float x) { return __builtin_amdgcn_exp2f(x); }
__device__ __forceinline__ float sigmoidf_(float x) { return __builtin_amdgcn_rcpf(1.0f + fast_exp2(-1.4426950408889634f * x)); }

constexpr size_t KiB = 1024, MiB = 1u << 20;
constexpr size_t WS_CTL = 0, CTL_ZERO_BYTES = 64 * KiB;
constexpr size_t WS_COND = 64 * KiB;
constexpr size_t WS_BINP = WS_COND + (size_t)DEPTH * BATCH * NCOND * 4;
constexpr size_t WS_ROPEC = WS_BINP + (size_t)DEPTH * NPAD * 4;
constexpr size_t WS_ROPES = WS_ROPEC + (size_t)MROWS * 32 * 4;
constexpr size_t WS_NG = WS_ROPES + (size_t)MROWS * 32 * 4;
constexpr size_t WS_KCMP = WS_NG + (size_t)MROWS * 24 * 4;
constexpr size_t WS_VCMP = WS_KCMP + (size_t)BATCH * 2 * 128 * 64 * 2;
constexpr size_t WS_W = WS_VCMP + (size_t)BATCH * 2 * 128 * 64 * 2;
constexpr size_t W_IN = 0, W_UP = W_IN + (size_t)NPAD * DM * 2, W_O = W_UP + (size_t)DM * DM * 2, W_F1 = W_O + (size_t)DM * DM * 2, W_F2 = W_F1 + (size_t)DFF * DM * 2, W_LAYER = W_F2 + (size_t)DM * DFF * 2;
constexpr size_t WS_CW = WS_W + DEPTH * W_LAYER;
constexpr size_t CW_W1T = 0, CW_W2T = 8 * MiB, CW_B1 = CW_W2T + 256 * KiB;
constexpr size_t WS_A1 = WS_CW + 9 * MiB;
constexpr size_t ARENA_B = 16 * MiB;
constexpr size_t WS_MG = WS_A1, WS_ZC = WS_A1 + 8 * MiB, WS_U = WS_ZC, WS_Q = WS_A1 + 14 * MiB;
constexpr size_t XE_MG = (ARENA_B - (size_t)SEQ * 2048 * 2) / 2, XE_ZC = (ARENA_B - (size_t)SEQ * 1536 * 2) / 2, XE_U = (ARENA_B - (size_t)SEQ * 1024 * 2) / 2, XE_Q = (ARENA_B - (size_t)SEQ * 512 * 2) / 2;
constexpr size_t WS_KV = WS_A1 + 256 * MiB;
constexpr size_t WS_CVAO = WS_KV + 48 * MiB, WS_H = WS_CVAO;
constexpr size_t WS_END = WS_CVAO + 64 * MiB;
static_assert(WS_END <= 512 * MiB, "workspace map exceeds 512 MiB");
static_assert(WS_ROPEC % 256 == 0 && WS_W % 256 == 0 && WS_A1 % 256 == 0, "alignment");
constexpr int CW_BAR = 1024;

namespace pg8 {
typedef unsigned u32x2 __attribute__((ext_vector_type(2)));
struct EpiIn {
    static constexpr bool PERM = true, AFTER_DRAIN = false; static constexpr int MID_T = 0;
    GAS unsigned char* ws; const GAS float* bias;
    __device__ __forceinline__ void operator()(const f32x4 (&acc)[2][2][4][2], const Unit& u, int wr, int wc, int fr, int fq) const {
        const size_t bt = (size_t)(u.pm >> 3);
        GAS bf16_t* ZC = (GAS bf16_t*)(ws + WS_ZC) + bt * XE_ZC; GAS bf16_t* Q = (GAS bf16_t*)(ws + WS_Q) + bt * XE_Q; GAS bf16_t* KV = (GAS bf16_t*)(ws + WS_KV); GAS bf16_t* MG = (GAS bf16_t*)(ws + WS_MG) + bt * XE_MG; GAS float* NG = (GAS float*)(ws + WS_NG);
        const GAS float* RC = (const GAS float*)(ws + WS_ROPEC); const GAS float* RS = (const GAS float*)(ws + WS_ROPES);
        const int row0 = u.pm * BM + wr * 64 + fr;
        const int pc0 = u.pn * BM + wc * 32 + 8 * fq;
        f32x4 bv[2][2];
#pragma unroll
        for (int bj = 0; bj < 2; ++bj)
#pragma unroll
            for (int n = 0; n < 2; ++n) bv[bj][n] = *(const GAS f32x4*)(bias + pc0 + bj * HALF + 4 * n);
        const int pn = u.pn;
        if (pn < 6) {
#pragma unroll
            for (int ai = 0; ai < 2; ++ai)
#pragma unroll
                for (int m = 0; m < 4; ++m) { GAS bf16_t* rowp = ZC + (size_t)(row0 + ai * HALF + m * 16) * 1536 + pc0;
#pragma unroll
                    for (int bj = 0; bj < 2; ++bj) { const f32x4 v0 = acc[ai][bj][m][0] + bv[bj][0], v1 = acc[ai][bj][m][1] + bv[bj][1];
                        u32x4 w; w.x = cvt_pk_bf16(v0[0], v0[1]); w.y = cvt_pk_bf16(v0[2], v0[3]); w.z = cvt_pk_bf16(v1[0], v1[1]); w.w = cvt_pk_bf16(v1[2], v1[3]);
                        *(GAS u32x4*)(rowp + bj * HALF) = w; } }
        } else if (pn < 11) {
#pragma unroll
            for (int ai = 0; ai < 2; ++ai)
#pragma unroll
                for (int m = 0; m < 4; ++m) { const int row = row0 + ai * HALF + m * 16;
                    if (pn < 8 || wc < 2) {
                        const f32x4 c0 = *(const GAS f32x4*)(RC + (size_t)row * 32 + 8 * fq), c1 = *(const GAS f32x4*)(RC + (size_t)row * 32 + 8 * fq + 4);
                        const f32x4 s0 = *(const GAS f32x4*)(RS + (size_t)row * 32 + 8 * fq), s1 = *(const GAS f32x4*)(RS + (size_t)row * 32 + 8 * fq + 4);
                        const f32x4 xa0 = acc[ai][0][m][0] + bv[0][0], xa1 = acc[ai][0][m][1] + bv[0][1], xb0 = acc[ai][1][m][0] + bv[1][0], xb1 = acc[ai][1][m][1] + bv[1][1];
                        const float sc = (pn < 8) ? 0.18033688011112042f : 1.0f;
                        const f32x4 o10 = (xa0 * c0 - xb0 * s0) * sc, o11 = (xa1 * c1 - xb1 * s1) * sc, o20 = (xb0 * c0 + xa0 * s0) * sc, o21 = (xb1 * c1 + xa1 * s1) * sc;
                        GAS bf16_t* d = (pn < 8) ? Q + (size_t)row * 512 + (4 * (pn - 6) + wc) * 64 + 8 * fq : KV + (size_t)row * 768 + (pn - 8) * 256 + wc * 64 + 8 * fq;
                        u32x4 a, b; a.x = cvt_pk_bf16(o10[0], o10[1]); a.y = cvt_pk_bf16(o10[2], o10[3]); a.z = cvt_pk_bf16(o11[0], o11[1]); a.w = cvt_pk_bf16(o11[2], o11[3]);
                        b.x = cvt_pk_bf16(o20[0], o20[1]); b.y = cvt_pk_bf16(o20[2], o20[3]); b.z = cvt_pk_bf16(o21[0], o21[1]); b.w = cvt_pk_bf16(o21[2], o21[3]);
                        *(GAS u32x4*)d = a; *(GAS u32x4*)(d + 32) = b;
                    } else {
#pragma unroll
                        for (int bj = 0; bj < 2; ++bj) { const f32x4 x1 = acc[ai][bj][m][0] + bv[bj][0], x2 = acc[ai][bj][m][1] + bv[bj][1];
                            GAS bf16_t* d = KV + (size_t)row * 768 + (pn - 8) * 256 + 128 + bj * 64 + (wc - 2) * 32 + 8 * fq;
                            u32x4 w; w.x = cvt_pk_bf16(x1[0], x1[1]); w.y = cvt_pk_bf16(x1[2], x1[3]); w.z = cvt_pk_bf16(x2[0], x2[1]); w.w = cvt_pk_bf16(x2[2], x2[3]);
                            *(GAS u32x4*)d = w; }
                    } }
        } else if (pn == 11) {
            if (wc == 0 && fq < 3) {
#pragma unroll
                for (int ai = 0; ai < 2; ++ai)
#pragma unroll
                    for (int m = 0; m < 4; ++m) { GAS float* d = NG + (size_t)(row0 + ai * HALF + m * 16) * 24 + 8 * fq;
                        *(GAS f32x4*)d = acc[ai][0][m][0] + bv[0][0]; *(GAS f32x4*)(d + 4) = acc[ai][0][m][1] + bv[0][1]; }
            }
        } else {
#pragma unroll
            for (int ai = 0; ai < 2; ++ai)
#pragma unroll
                for (int m = 0; m < 4; ++m) { GAS bf16_t* rowp = MG + (size_t)(row0 + ai * HALF + m * 16) * 2048 + (pn - 12) * 128 + wc * 32 + 8 * fq;
                    f32x4 c0 = acc[ai][0][m][0] + bv[0][0], c1 = acc[ai][0][m][1] + bv[0][1], a0 = acc[ai][1][m][0] + bv[1][0], a1 = acc[ai][1][m][1] + bv[1][1];
#pragma unroll
                    for (int j = 0; j < 4; ++j) { a0[j] = fmaxf(sigmoidf_(a0[j]), 9.5367431640625e-07f); a1[j] = fmaxf(sigmoidf_(a1[j]), 9.5367431640625e-07f);
                        c0[j] = sigmoidf_(c0[j]) * __builtin_amdgcn_rcpf(a0[j]); c1[j] = sigmoidf_(c1[j]) * __builtin_amdgcn_rcpf(a1[j]); }
                    u32x4 wr_, wa_; wr_.x = cvt_pk_bf16(c0[0], c0[1]); wr_.y = cvt_pk_bf16(c0[2], c0[3]); wr_.z = cvt_pk_bf16(c1[0], c1[1]); wr_.w = cvt_pk_bf16(c1[2], c1[3]);
                    wa_.x = cvt_pk_bf16(a0[0], a0[1]); wa_.y = cvt_pk_bf16(a0[2], a0[3]); wa_.z = cvt_pk_bf16(a1[0], a1[1]); wa_.w = cvt_pk_bf16(a1[2], a1[3]);
                    *(GAS u32x4*)rowp = wr_; *(GAS u32x4*)(rowp + 1024) = wa_; }
        }
    }
};
template <int PASS> struct EpiUp {
    static constexpr bool PERM = true, AFTER_DRAIN = false; static constexpr int MID_T = 0;
    GAS bf16_t* U; const GAS bf16_t* MG;
    __device__ __forceinline__ void operator()(const f32x4 (&acc)[2][2][4][2], const Unit& u, int wr, int wc, int fr, int fq) const {
        const int row0 = u.pm * BM + wr * 64 + fr, col0 = u.pn * BM + wc * 32 + 8 * fq;
#pragma unroll
        for (int ai = 0; ai < 2; ++ai)
#pragma unroll
            for (int mh = 0; mh < 2; ++mh) {
                u32x4 gt[2][2], pv[2][2];
#pragma unroll
                for (int m2 = 0; m2 < 2; ++m2) { const size_t row = (size_t)(row0 + ai * HALF + (2 * mh + m2) * 16);
#pragma unroll
                    for (int bj = 0; bj < 2; ++bj) { gt[m2][bj] = *(const GAS u32x4*)(MG + row * 2048 + PASS * 1024 + col0 + bj * HALF);
                        if (PASS == 1) pv[m2][bj] = *(const GAS u32x4*)(U + row * 1024 + col0 + bj * HALF); } }
                asm volatile("" ::: "memory");
#pragma unroll
                for (int m2 = 0; m2 < 2; ++m2) { const size_t row = (size_t)(row0 + ai * HALF + (2 * mh + m2) * 16);
#pragma unroll
                    for (int bj = 0; bj < 2; ++bj) { const u32x4 g = gt[m2][bj];
                        f32x4 v0 = acc[ai][bj][2 * mh + m2][0], v1 = acc[ai][bj][2 * mh + m2][1];
                        v0[0] *= bf_lo(g.x); v0[1] *= bf_hi(g.x); v0[2] *= bf_lo(g.y); v0[3] *= bf_hi(g.y);
                        v1[0] *= bf_lo(g.z); v1[1] *= bf_hi(g.z); v1[2] *= bf_lo(g.w); v1[3] *= bf_hi(g.w);
                        if (PASS == 1) { const u32x4 p = pv[m2][bj];
                            v0[0] += bf_lo(p.x); v0[1] += bf_hi(p.x); v0[2] += bf_lo(p.y); v0[3] += bf_hi(p.y);
                            v1[0] += bf_lo(p.z); v1[1] += bf_hi(p.z); v1[2] += bf_lo(p.w); v1[3] += bf_hi(p.w); }
                        u32x4 w; w.x = cvt_pk_bf16(v0[0], v0[1]); w.y = cvt_pk_bf16(v0[2], v0[3]); w.z = cvt_pk_bf16(v1[0], v1[1]); w.w = cvt_pk_bf16(v1[2], v1[3]);
                        *(GAS u32x4*)(U + row * 1024 + col0 + bj * HALF) = w; } }
                asm volatile("" ::: "memory");
            }
    }
};
struct EpiUpM {
    static constexpr bool PERM = true, AFTER_DRAIN = false; static constexpr int MID_T = 8;
    GAS bf16_t* U0; const GAS bf16_t* MG0;
    __device__ __forceinline__ void mid(f32x4 (&acc)[2][2][4][2], const Unit& u, int wr, int wc, int fr, int fq) const {
        const GAS bf16_t* MG = MG0 + (size_t)(u.pm >> 3) * XE_MG;
        const int row0 = u.pm * BM + wr * 64 + fr, col0 = u.pn * BM + wc * 32 + 8 * fq;
#pragma unroll
        for (int ai = 0; ai < 2; ++ai) {
            u32x4 gr[4][2];
#pragma unroll
            for (int m = 0; m < 4; ++m)
#pragma unroll
                for (int bj = 0; bj < 2; ++bj) gr[m][bj] = *(const GAS u32x4*)(MG + (size_t)(row0 + ai * HALF + m * 16) * 2048 + col0 + bj * HALF);
#pragma unroll
            for (int m = 0; m < 4; ++m)
#pragma unroll
                for (int bj = 0; bj < 2; ++bj) { const u32x4 c = gr[m][bj];
                    f32x4& v0 = acc[ai][bj][m][0]; f32x4& v1 = acc[ai][bj][m][1];
                    v0[0] *= bf_lo(c.x); v0[1] *= bf_hi(c.x); v0[2] *= bf_lo(c.y); v0[3] *= bf_hi(c.y);
                    v1[0] *= bf_lo(c.z); v1[1] *= bf_hi(c.z); v1[2] *= bf_lo(c.w); v1[3] *= bf_hi(c.w); }
        }
    }
    __device__ __forceinline__ void operator()(const f32x4 (&acc)[2][2][4][2], const Unit& u, int wr, int wc, int fr, int fq) const {
        const GAS bf16_t* MG = MG0 + (size_t)(u.pm >> 3) * XE_MG; GAS bf16_t* U = U0 + (size_t)(u.pm >> 3) * XE_U;
        const int row0 = u.pm * BM + wr * 64 + fr, col0 = u.pn * BM + wc * 32 + 8 * fq;
#pragma unroll
        for (int ai = 0; ai < 2; ++ai) {
            u32x4 ga[4][2];
#pragma unroll
            for (int m = 0; m < 4; ++m)
#pragma unroll
                for (int bj = 0; bj < 2; ++bj) ga[m][bj] = *(const GAS u32x4*)(MG + (size_t)(row0 + ai * HALF + m * 16) * 2048 + 1024 + col0 + bj * HALF);
#pragma unroll
            for (int m = 0; m < 4; ++m) { const size_t row = (size_t)(row0 + ai * HALF + m * 16);
#pragma unroll
                for (int bj = 0; bj < 2; ++bj) { const u32x4 a = ga[m][bj];
                    f32x4 v0 = acc[ai][bj][m][0], v1 = acc[ai][bj][m][1];
                    v0[0] *= bf_lo(a.x); v0[1] *= bf_hi(a.x); v0[2] *= bf_lo(a.y); v0[3] *= bf_hi(a.y);
                    v1[0] *= bf_lo(a.z); v1[1] *= bf_hi(a.z); v1[2] *= bf_lo(a.w); v1[3] *= bf_hi(a.w);
                    u32x4 w; w.x = cvt_pk_bf16(v0[0], v0[1]); w.y = cvt_pk_bf16(v0[2], v0[3]); w.z = cvt_pk_bf16(v1[0], v1[1]); w.w = cvt_pk_bf16(v1[2], v1[3]);
                    *(GAS u32x4*)(U + row * 1024 + col0 + bj * HALF) = w; } }
        }
    }
};
struct EpiRes {
    static constexpr bool PERM = true, AFTER_DRAIN = false; static constexpr int MID_T = 0;
    const GAS float* base32; GAS bf16_t* XR; const GAS float* gate;
    __device__ __forceinline__ void operator()(const f32x4 (&acc)[2][2][4][2], const Unit& u, int wr, int wc, int fr, int fq) const {
        const int row0 = u.pm * BM + wr * 64 + fr, col0 = u.pn * BM + wc * 32 + 8 * fq;
        const GAS float* gp = gate + (size_t)(u.pm >> 3) * 6144 + col0;
        f32x4 gv[2][2];
#pragma unroll
        for (int bj = 0; bj < 2; ++bj)
#pragma unroll
            for (int n = 0; n < 2; ++n) gv[bj][n] = *(const GAS f32x4*)(gp + bj * HALF + n * 4);
        if (base32) {
#pragma unroll
            for (int ai = 0; ai < 2; ++ai)
#pragma unroll
                for (int m = 0; m < 4; ++m) { const size_t row = (size_t)(row0 + ai * HALF + m * 16);
#pragma unroll
                    for (int bj = 0; bj < 2; ++bj) { const f32x4 b0 = *(const GAS f32x4*)(base32 + row * 1024 + col0 + bj * HALF), b1 = *(const GAS f32x4*)(base32 + row * 1024 + col0 + bj * HALF + 4);
                        const f32x4 o0 = b0 + gv[bj][0] * acc[ai][bj][m][0], o1 = b1 + gv[bj][1] * acc[ai][bj][m][1];
                        u32x4 w; w.x = cvt_pk_bf16(o0[0], o0[1]); w.y = cvt_pk_bf16(o0[2], o0[3]); w.z = cvt_pk_bf16(o1[0], o1[1]); w.w = cvt_pk_bf16(o1[2], o1[3]);
                        *(GAS u32x4*)(XR + row * XRP + col0 + bj * HALF) = w; } }
        } else {
#pragma unroll
            for (int ai = 0; ai < 2; ++ai) {
                u32x4 bs[4][2];
#pragma unroll
                for (int m = 0; m < 4; ++m)
#pragma unroll
                    for (int bj = 0; bj < 2; ++bj) bs[m][bj] = *(const GAS u32x4*)(XR + (size_t)(row0 + ai * HALF + m * 16) * XRP + col0 + bj * HALF);
                asm volatile("" ::: "memory");
#pragma unroll
                for (int m = 0; m < 4; ++m)
#pragma unroll
                    for (int bj = 0; bj < 2; ++bj) { const u32x4 b = bs[m][bj];
                        const f32x4 b0 = (f32x4){bf_lo(b.x), bf_hi(b.x), bf_lo(b.y), bf_hi(b.y)}, b1 = (f32x4){bf_lo(b.z), bf_hi(b.z), bf_lo(b.w), bf_hi(b.w)};
                        const f32x4 o0 = b0 + gv[bj][0] * acc[ai][bj][m][0], o1 = b1 + gv[bj][1] * acc[ai][bj][m][1];
                        u32x4 w; w.x = cvt_pk_bf16(o0[0], o0[1]); w.y = cvt_pk_bf16(o0[2], o0[3]); w.z = cvt_pk_bf16(o1[0], o1[1]); w.w = cvt_pk_bf16(o1[2], o1[3]);
                        *(GAS u32x4*)(XR + (size_t)(row0 + ai * HALF + m * 16) * XRP + col0 + bj * HALF) = w; }
                asm volatile("" ::: "memory");
            }
        }
    }
};
struct EpiFf1 {
    static constexpr bool PERM = true, AFTER_DRAIN = false; static constexpr int MID_T = 0;
    GAS bf16_t* O;
    __device__ __forceinline__ void operator()(const f32x4 (&acc)[2][2][4][2], const Unit& u, int wr, int wc, int fr, int fq) const {
        const int row0 = u.pm * BM + wr * 64 + fr, col0 = u.pn * BM + wc * 32 + 8 * fq;
#pragma unroll
        for (int ai = 0; ai < 2; ++ai)
#pragma unroll
            for (int m = 0; m < 4; ++m) { GAS bf16_t* rowp = O + (size_t)(row0 + ai * HALF + m * 16) * 4096 + col0;
#pragma unroll
                for (int bj = 0; bj < 2; ++bj) { f32x4 v0 = acc[ai][bj][m][0], v1 = acc[ai][bj][m][1];
#pragma unroll
                    for (int j = 0; j < 4; ++j) { const float a = fmaxf(v0[j], 0.f), b = fmaxf(v1[j], 0.f); v0[j] = a * a; v1[j] = b * b; }
                    u32x4 w; w.x = cvt_pk_bf16(v0[0], v0[1]); w.y = cvt_pk_bf16(v0[2], v0[3]); w.z = cvt_pk_bf16(v1[0], v1[1]); w.w = cvt_pk_bf16(v1[2], v1[3]);
                    *(GAS u32x4*)(rowp + bj * HALF) = w; } }
    }
};

struct OneUnit {
    bool active; int pm;
    __device__ __forceinline__ bool next(int i, Unit& u) const { if (i == 0 && active) { u.pm = pm; u.pn = 0; return true; } return false; }
    __device__ __forceinline__ void a_ready(const Unit&) const {}
    __device__ __forceinline__ void done(const Unit&) const {}
};
struct OneUnitSig {
    bool active; int pm; GAS unsigned* flag;
    __device__ __forceinline__ bool next(int i, Unit& u) const { if (i == 0 && active) { u.pm = pm; u.pn = 0; return true; } return false; }
    __device__ __forceinline__ void a_ready(const Unit&) const {}
    __device__ __forceinline__ void done(const Unit&) const {
        asm volatile("s_waitcnt vmcnt(0)" ::: "memory");
        if (__builtin_amdgcn_mbcnt_hi(~0u, __builtin_amdgcn_mbcnt_lo(~0u, 0u)) == 0u) (void)__hip_atomic_fetch_add(flag, 1u, __ATOMIC_RELAXED, __HIP_MEMORY_SCOPE_AGENT);
    }
};
struct EpiCmpPart {
    static constexpr bool PERM = true, AFTER_DRAIN = false; static constexpr int MID_T = 0;
    GAS unsigned char* part;
    __device__ __forceinline__ void operator()(const f32x4 (&acc)[2][2][4][2], const Unit& u, int wr, int wc, int fr, int fq) const {
        const int col0 = wc * 32 + 8 * fq;
#pragma unroll
        for (int ai = 0; ai < 2; ++ai)
#pragma unroll
            for (int m = 0; m < 4; ++m) { GAS unsigned char* rowp = part + (size_t)(ai * HALF + wr * 64 + m * 16 + fr) * 4096 + col0 * 2;
#pragma unroll
                for (int bj = 0; bj < 2; ++bj) { const f32x4 v0 = acc[ai][bj][m][0], v1 = acc[ai][bj][m][1];
                    u32x4 w; w.x = cvt_pk_bf16(v0[0], v0[1]); w.y = cvt_pk_bf16(v0[2], v0[3]); w.z = cvt_pk_bf16(v1[0], v1[1]); w.w = cvt_pk_bf16(v1[2], v1[3]);
                    *(GAS u32x4*)(rowp + bj * HALF * 2) = w; } }
    }
};
struct EpiCmp {
    static constexpr bool PERM = true, AFTER_DRAIN = true; static constexpr int MID_T = 0;
    const GAS float* bias1; const GAS bf16_t* W2T; GAS bf16_t* OUT; const GAS unsigned char* part; GAS unsigned* flag;
    __device__ __forceinline__ void fused(f32x4 (&acc)[2][2][4][2], const Unit& u, int wr, int wc, int fr, int fq, PG8_LAS unsigned char* lds, int wid, int lane) const {
        const int col0 = wc * 32 + 8 * fq;
        if (wid == 0 && lane == 0) { unsigned sp = 0u;
            while (__hip_atomic_load(flag, __ATOMIC_RELAXED, __HIP_MEMORY_SCOPE_AGENT) < 8u) { __builtin_amdgcn_s_sleep(1); if (++sp > (1u << 22)) break; }
            __builtin_amdgcn_fence(__ATOMIC_ACQUIRE, "agent"); asm volatile("s_waitcnt vmcnt(0)" ::: "memory"); }
        asm volatile("s_waitcnt lgkmcnt(0)" ::: "memory"); __builtin_amdgcn_s_barrier(); asm volatile("" ::: "memory");
#pragma unroll
        for (int ai = 0; ai < 2; ++ai) {
            u32x4 pp[4][2];
#pragma unroll
            for (int m = 0; m < 4; ++m)
#pragma unroll
                for (int bj = 0; bj < 2; ++bj) pp[m][bj] = *(const GAS u32x4*)(part + (size_t)(ai * HALF + wr * 64 + m * 16 + fr) * 4096 + (col0 + bj * HALF) * 2);
#pragma unroll
            for (int m = 0; m < 4; ++m)
#pragma unroll
                for (int bj = 0; bj < 2; ++bj) { const u32x4 p = pp[m][bj];
                    acc[ai][bj][m][0] += (f32x4){bf_lo(p.x), bf_hi(p.x), bf_lo(p.y), bf_hi(p.y)}; acc[ai][bj][m][1] += (f32x4){bf_lo(p.z), bf_hi(p.z), bf_lo(p.w), bf_hi(p.w)}; }
        }
        f32x4 bv[2][2];
#pragma unroll
        for (int bj = 0; bj < 2; ++bj)
#pragma unroll
            for (int n = 0; n < 2; ++n) { f32x4 s = *(const GAS f32x4*)(bias1 + col0 + bj * HALF + 4 * n);
#pragma unroll
                for (int p = 1; p < 8; ++p) s += *(const GAS f32x4*)(bias1 + p * 256 + col0 + bj * HALF + 4 * n);
                bv[bj][n] = s; }
#pragma unroll
        for (int ai = 0; ai < 2; ++ai)
#pragma unroll
            for (int m = 0; m < 4; ++m) { const int row = ai * HALF + wr * 64 + m * 16 + fr;
#pragma unroll
                for (int bj = 0; bj < 2; ++bj) { f32x4 v0 = acc[ai][bj][m][0] + bv[bj][0], v1 = acc[ai][bj][m][1] + bv[bj][1];
#pragma unroll
                    for (int j = 0; j < 4; ++j) { v0[j] = v0[j] * sigmoidf_(v0[j]); v1[j] = v1[j] * sigmoidf_(v1[j]); }
                    u32x4 w; w.x = cvt_pk_bf16(v0[0], v0[1]); w.y = cvt_pk_bf16(v0[2], v0[3]); w.z = cvt_pk_bf16(v1[0], v1[1]); w.w = cvt_pk_bf16(v1[2], v1[3]);
                    const int chunk = (col0 + bj * HALF) >> 3;
                    *(PG8_LAS u32x4*)(lds + row * 512 + ((chunk ^ (row & 15)) << 4)) = w; } }
        const int r = lane & 15, q = lane >> 4;
        bf16x8 bw[8][4];
#pragma unroll
        for (int ks = 0; ks < 8; ++ks)
#pragma unroll
            for (int ct = 0; ct < 4; ++ct) bw[ks][ct] = *(const GAS bf16x8*)(W2T + (size_t)(16 * ct + r) * 256 + 32 * ks + 8 * q);
        asm volatile("s_waitcnt lgkmcnt(0)" ::: "memory"); __builtin_amdgcn_s_barrier(); asm volatile("" ::: "memory");
        f32x4 o[2][4];
#pragma unroll
        for (int rt = 0; rt < 2; ++rt)
#pragma unroll
            for (int ct = 0; ct < 4; ++ct) o[rt][ct] = (f32x4){0.f, 0.f, 0.f, 0.f};
#pragma unroll
        for (int ks = 0; ks < 8; ++ks) {
            bf16x8 afr[2];
#pragma unroll
            for (int rt = 0; rt < 2; ++rt) { const int row = 32 * wid + 16 * rt + r; afr[rt] = *(const PG8_LAS bf16x8*)(lds + row * 512 + (((4 * ks + q) ^ (row & 15)) << 4)); }
#pragma unroll
            for (int rt = 0; rt < 2; ++rt)
#pragma unroll
                for (int ct = 0; ct < 4; ++ct) o[rt][ct] = __builtin_amdgcn_mfma_f32_16x16x32_bf16(bw[ks][ct], afr[rt], o[rt][ct], 0, 0, 0);
        }
#pragma unroll
        for (int rt = 0; rt < 2; ++rt) { const int row = 32 * wid + 16 * rt + r; const bool pad = (row & 127) == 127;
            GAS bf16_t* d = OUT + ((size_t)u.pm * 256 + row) * 64 + 4 * q;
#pragma unroll
            for (int ct = 0; ct < 4; ++ct) { u32x2 w; w.x = pad ? 0u : cvt_pk_bf16(o[rt][ct][0], o[rt][ct][1]); w.y = pad ? 0u : cvt_pk_bf16(o[rt][ct][2], o[rt][ct][3]);
                *(GAS u32x2*)(d + 16 * ct) = w; } }
    }
};
}

constexpr int RING_BYTES = 131072, LDSCTL_OFF = RING_BYTES, MISC_OFF = LDSCTL_OFF + 320, LDS_BYTES = 147456;
constexpr int NWAVES = 8;

#define XB_TMO      128
#define XB_XCNT(j)  (256  + 64 * (j))
#define XB_XSUB(j)  (1280 + 64 * (j))
#define XB_XGEN(j)  (2304 + 64 * (j))
#define XB_TOP      3328
#define XB_TOPGEN   3392
#define XCD_BAR_WORDS 3456
#define XB_SPIN_CAP (1u << 18)
static_assert((CW_BAR + XCD_BAR_WORDS) * 4 <= (int)CTL_ZERO_BYTES, "barrier words inside the memset region");
__device__ __forceinline__ unsigned xb_ld(GAS unsigned* p)              { return __hip_atomic_load(p, __ATOMIC_RELAXED, __HIP_MEMORY_SCOPE_AGENT); }
__device__ __forceinline__ unsigned xb_add(GAS unsigned* p, unsigned v) { return __hip_atomic_fetch_add(p, v, __ATOMIC_RELAXED, __HIP_MEMORY_SCOPE_AGENT); }
__device__ __forceinline__ unsigned xb_xcc_id() { return (unsigned)__builtin_amdgcn_s_getreg((3 << 11) | 20) & 0xFu; }
#define XB_SPIN(cond, bar) do { unsigned _sp = 0; while (cond) { __builtin_amdgcn_s_sleep(1); \
    if ((++_sp & 255u) == 0u) { if (xb_ld(&(bar)[XB_TMO])) break; if (_sp > XB_SPIN_CAP) { atomicAdd((unsigned*)&(bar)[XB_TMO], 1u); break; } } } } while (0)
struct XcdBarrier { GAS unsigned* bar; unsigned x; volatile LAS unsigned* st; };
__device__ __forceinline__ XcdBarrier xcd_barrier_post(GAS unsigned* bar, volatile LAS unsigned* st, int tid) {
    XcdBarrier b; b.bar = bar; b.x = xb_xcc_id(); b.st = st;
    if (tid == 0) st[2] = xb_add(&bar[XB_XCNT(b.x)], 1u);
    return b;
}
__device__ __forceinline__ void xcd_barrier_complete(GAS unsigned* bar, unsigned x, unsigned& nloc, unsigned& nx, unsigned& didx) {
    const unsigned G = gridDim.x * gridDim.y * gridDim.z;
    unsigned sum, cnt, mine, sp = 0u;
    for (;;) {
        sum = 0u; cnt = 0u; mine = 0u; didx = 0u;
#pragma unroll 1
        for (unsigned j = 0; j < 16; ++j) { const unsigned c = xb_ld(&bar[XB_XCNT(j)]); sum += c; cnt += (c > 0u) ? 1u : 0u; mine = (j == x) ? c : mine; didx += (j < x && c > 0u) ? 1u : 0u; }
        if (sum == G) break;
        __builtin_amdgcn_s_sleep(1);
        if ((++sp & 255u) == 0u) { if (xb_ld(&bar[XB_TMO])) break; if (sp > XB_SPIN_CAP) { atomicAdd((unsigned*)&bar[XB_TMO], 1u); break; } }
    }
    nloc = mine > 0u ? mine : 1u; nx = cnt > 0u ? cnt : 1u;
}
__device__ __forceinline__ void xcd_barrier(const XcdBarrier& b, int wave) {
    asm volatile("s_waitcnt vmcnt(0)" ::: "memory");
    __syncthreads();
    if (wave == 0 && __builtin_amdgcn_mbcnt_hi(~0u, __builtin_amdgcn_mbcnt_lo(~0u, 0u)) == 0u) {
        GAS unsigned* bar = b.bar; unsigned bx = b.x;
        asm volatile("" : "+s"(bar), "+s"(bx));
        __builtin_amdgcn_s_waitcnt(0);
        unsigned nloc = b.st[0], nx = b.st[1];
        if (nloc == 0u) { unsigned didx; xcd_barrier_complete(bar, bx, nloc, nx, didx); b.st[0] = nloc; b.st[1] = nx;
            const unsigned b0 = didx * (unsigned)BATCH / nx, b1 = (didx + 1u) * (unsigned)BATCH / nx; b.st[4] = b0; b.st[5] = b1 - b0; }
        const unsigned old = xb_add(&bar[XB_XSUB(bx)], 1u);
        const unsigned gen = old / nloc;
        if (old + 1u == (gen + 1u) * nloc) {
            __builtin_amdgcn_fence(__ATOMIC_RELEASE, "agent");
            asm volatile("s_waitcnt vmcnt(0)" ::: "memory");
            const unsigned og = xb_add(&bar[XB_TOP], 1u);
            const unsigned tg = og / nx;
            if (og + 1u == (tg + 1u) * nx) xb_add(&bar[XB_TOPGEN], 1u);
            else XB_SPIN(xb_ld(&bar[XB_TOPGEN]) == tg, bar);
            __builtin_amdgcn_fence(__ATOMIC_ACQUIRE, "agent");
            xb_add(&bar[XB_XGEN(bx)], 1u);
            asm volatile("s_waitcnt vmcnt(0)" ::: "memory");
        } else {
            XB_SPIN(xb_ld(&bar[XB_XGEN(bx)]) == gen, bar);
            __builtin_amdgcn_fence(__ATOMIC_ACQUIRE, "agent");
            asm volatile("s_waitcnt vmcnt(0)" ::: "memory");
        }
    }
    __syncthreads();
}

__device__ __forceinline__ void dom_barrier(const XcdBarrier& b, int wave) {
    asm volatile("s_waitcnt vmcnt(0)" ::: "memory");
    __syncthreads();
    if (wave == 0 && __builtin_amdgcn_mbcnt_hi(~0u, __builtin_amdgcn_mbcnt_lo(~0u, 0u)) == 0u) {
        GAS unsigned* bar = b.bar; unsigned bx = b.x;
        asm volatile("" : "+s"(bar), "+s"(bx));
        __builtin_amdgcn_s_waitcnt(0);
        const unsigned nloc = b.st[0];
        const unsigned old = xb_add(&bar[XB_XSUB(bx)], 1u);
        const unsigned gen = old / nloc;
        if (old + 1u == (gen + 1u) * nloc) xb_add(&bar[XB_XGEN(bx)], 1u);
        else XB_SPIN(xb_ld(&bar[XB_XGEN(bx)]) == gen, bar);
        __builtin_amdgcn_fence(__ATOMIC_ACQUIRE, "agent");
        asm volatile("s_waitcnt vmcnt(0)" ::: "memory");
    }
    __syncthreads();
}

struct Frame {
    LAS unsigned char* lds;
    int tid, lane, wave, vcu, G;
    int rk, nl, b0, nb;
    GAS float* out; GAS unsigned char* ws;
};
constexpr int PTR_OFF = 131072 + 1024;
__device__ __forceinline__ const GAS float* INP(const Frame& F, int i) {
    unsigned a = (unsigned)(PTR_OFF + 8 * i); asm volatile("" : "+v"(a));
    const unsigned long long v = *(const LAS unsigned long long*)(F.lds + a);
    const unsigned lo = (unsigned)__builtin_amdgcn_readfirstlane((int)(unsigned)v), hi = (unsigned)__builtin_amdgcn_readfirstlane((int)(unsigned)(v >> 32));
    return (const GAS float*)(((unsigned long long)hi << 32) | lo);
}
#define LDS_WAIT() asm volatile("s_waitcnt lgkmcnt(0)" ::: "memory")
constexpr int DOM_OFF = 131072 + 320 + 32;
__device__ __forceinline__ void dom_load(Frame& F) {
    unsigned a = (unsigned)DOM_OFF; asm volatile("" : "+v"(a));
    const LAS unsigned* st = (const LAS unsigned*)(F.lds + a);
    F.nl = __builtin_amdgcn_readfirstlane((int)st[0]); F.rk = __builtin_amdgcn_readfirstlane((int)st[2]); F.b0 = __builtin_amdgcn_readfirstlane((int)st[4]); F.nb = __builtin_amdgcn_readfirstlane((int)st[5]);
}
__device__ __forceinline__ float wave_sum(float v) {
#pragma unroll
    for (int o = 1; o < 64; o <<= 1) v += __shfl_xor(v, o);
    return v;
}
__device__ __forceinline__ float wave_max(float v) {
#pragma unroll
    for (int o = 1; o < 64; o <<= 1) v = fmaxf(v, __shfl_xor(v, o));
    return v;
}
__device__ __forceinline__ float rdlane(float v, int l) { return __int_as_float(__builtin_amdgcn_readlane(__float_as_int(v), l)); }

__device__ __forceinline__ int cmap_in(int p) {
    if (p < 1536) return p;
    if (p < 2048) { const int t = (p - 1536) >> 8, q = (p - 1536) & 255, bj = q >> 7, r = q & 127; return 1536 + (4 * t + (r >> 5)) * 64 + bj * 32 + (r & 31); }
    if (p < 2816) { const int seg = (p - 2048) >> 8, q = (p - 2048) & 255, bj = q >> 7, r = q & 127;
        if (r < 64) return 2048 + seg * 256 + (r >> 5) * 64 + bj * 32 + (r & 31);
        return 2048 + seg * 256 + 128 + bj * 64 + (r - 64); }
    if (p < 3072) { const int q = p - 2816; return q < 24 ? 2816 + q : -1; }
    { const int t = (p - 3072) >> 8, q = (p - 3072) & 255, bj = q >> 7, r = q & 127; return 2840 + bj * 1024 + 128 * t + r; }
}
struct TrDesc { const GAS float* W; GAS bf16* WT; int ldw, nblk, ldt, kdst0, item; bool mapped; };
struct TrRegs { f32x4 v[8]; };
__device__ __forceinline__ void tr_load(const TrDesc& d, TrRegs& t, int lane) {
    const int kb = d.item / d.nblk, nb = d.item % d.nblk, k0 = 64 * kb, p0 = 32 * nb;
    const int kk = lane >> 3, ch = lane & 7;
    const int c = d.mapped ? cmap_in(p0 + 4 * ch) : p0 + 4 * ch;
#pragma unroll
    for (int i = 0; i < 8; ++i) { const int k = 8 * i + kk;
        t.v[i] = (c >= 0) ? *(const GAS f32x4*)(d.W + (size_t)(k0 + k) * d.ldw + c) : (f32x4){0.f, 0.f, 0.f, 0.f}; }
}
__device__ __forceinline__ void tr_finish(const TrDesc& d, const TrRegs& t, LAS float* scr, int lane) {
    const int kb = d.item / d.nblk, nb = d.item % d.nblk, k0 = 64 * kb, p0 = 32 * nb;
    const int kk = lane >> 3, ch = lane & 7;
#pragma unroll
    for (int i = 0; i < 8; ++i) { const int k = 8 * i + kk; *(LAS f32x4*)(scr + k * 36 + 4 * ch) = t.v[i]; }
    LDS_WAIT(); asm volatile("" ::: "memory");
    const int cc = lane & 7;
#pragma unroll
    for (int j = 0; j < 4; ++j) { const int n = (lane >> 3) + 8 * j; const LAS float* s = scr + (8 * cc) * 36 + n;
        v4u o; o.x = pk2(s[0 * 36], s[1 * 36]); o.y = pk2(s[2 * 36], s[3 * 36]); o.z = pk2(s[4 * 36], s[5 * 36]); o.w = pk2(s[6 * 36], s[7 * 36]);
        *(GAS v4u*)(d.WT + (size_t)(p0 + n) * d.ldt + d.kdst0 + k0 + 8 * cc) = o; }
    LDS_WAIT(); asm volatile("" ::: "memory");
}

__device__ __forceinline__ void p0_prologue(Frame& F) {
    const int gw = F.vcu * NWAVES + F.wave, NGW = F.G * NWAVES;
    const int gtid = F.vcu * 512 + F.tid, NT = F.G * 512;
    {
        LAS float* cactT = (LAS float*)F.lds;
        LAS float* red = (LAS float*)(F.lds + 65536);
        const GAS float* c = INP(F, 1);
        for (int i = F.tid; i < BATCH * DM; i += 512) { const int b = i >> 10, k = i & 1023; const float v = c[i]; cactT[k * 16 + b] = v * sigmoidf_(v); }
        __syncthreads();
        for (int unit = F.vcu; unit < DEPTH * 64; unit += F.G) {
            const int l = unit >> 6, col0 = (unit & 63) * 96;
            const GAS float* wp = INP(F, 3) + (size_t)l * DM * NCOND + col0 + F.lane;
            const GAS float* wq = INP(F, 3) + (size_t)l * DM * NCOND + col0 + 64 + (F.lane & 31);
            float acc[16], acd[16];
#pragma unroll
            for (int b = 0; b < 16; ++b) { acc[b] = 0.f; acd[b] = 0.f; }
            const int kbeg = F.wave * 128;
#pragma unroll 32
            for (int k = kbeg; k < kbeg + 128; ++k) {
                const float wv = wp[(size_t)k * NCOND], wu = wq[(size_t)k * NCOND];
                const LAS f32x4* cp = (const LAS f32x4*)(cactT + k * 16);
                const f32x4 c0 = cp[0], c1 = cp[1], c2 = cp[2], c3 = cp[3];
                acc[0] += c0[0] * wv; acc[1] += c0[1] * wv; acc[2] += c0[2] * wv; acc[3] += c0[3] * wv;
                acc[4] += c1[0] * wv; acc[5] += c1[1] * wv; acc[6] += c1[2] * wv; acc[7] += c1[3] * wv;
                acc[8] += c2[0] * wv; acc[9] += c2[1] * wv; acc[10] += c2[2] * wv; acc[11] += c2[3] * wv;
                acc[12] += c3[0] * wv; acc[13] += c3[1] * wv; acc[14] += c3[2] * wv; acc[15] += c3[3] * wv;
                acd[0] += c0[0] * wu; acd[1] += c0[1] * wu; acd[2] += c0[2] * wu; acd[3] += c0[3] * wu;
                acd[4] += c1[0] * wu; acd[5] += c1[1] * wu; acd[6] += c1[2] * wu; acd[7] += c1[3] * wu;
                acd[8] += c2[0] * wu; acd[9] += c2[1] * wu; acd[10] += c2[2] * wu; acd[11] += c2[3] * wu;
                acd[12] += c3[0] * wu; acd[13] += c3[1] * wu; acd[14] += c3[2] * wu; acd[15] += c3[3] * wu;
            }
#pragma unroll
            for (int b = 0; b < 16; ++b) { red[(F.wave * 16 + b) * 96 + F.lane] = acc[b]; if (F.lane < 32) red[(F.wave * 16 + b) * 96 + 64 + F.lane] = acd[b]; }
            __syncthreads();
            GAS float* cond = (GAS float*)(F.ws + WS_COND) + (size_t)l * BATCH * NCOND;
            for (int o = F.tid; o < 16 * 96; o += 512) { const int b = o / 96, cl = o % 96; float s = INP(F, 4)[(size_t)l * NCOND + col0 + cl];
#pragma unroll
                for (int w = 0; w < 8; ++w) s += red[(w * 16 + b) * 96 + cl];
                cond[(size_t)b * NCOND + col0 + cl] = s; }
            __syncthreads();
        }
        __syncthreads();
    }
    if (F.vcu < 16 * DEPTH) {
        const int part = F.vcu & 7, lk = F.vcu >> 3, l = lk >> 1, kind = lk & 1;
        LAS float* red = (LAS float*)(F.lds + 65536);
        const GAS float* W1 = INP(F, kind ? 12 : 9) + (size_t)l * 2048 * 256 + 4 * F.lane;
        const GAS float* pe = INP(F, kind ? 14 : 11) + (size_t)l * 2048;
        const int kbeg = part * 256 + F.wave * 32;
        f32x4 wv[32];
#pragma unroll
        for (int i = 0; i < 32; ++i) wv[i] = *(const GAS f32x4*)(W1 + (size_t)(kbeg + i) * 256);
        f32x4 a4 = (f32x4){0.f, 0.f, 0.f, 0.f};
#pragma unroll
        for (int i = 0; i < 32; ++i) a4 += wv[i] * pe[kbeg + i];
        *(LAS f32x4*)(red + F.wave * 256 + 4 * F.lane) = a4;
        __syncthreads();
        if (F.tid < 256) { float sum = 0.f;
#pragma unroll
            for (int w = 0; w < 8; ++w) sum += red[w * 256 + F.tid];
            ((GAS float*)(F.ws + WS_CW + CW_B1))[(lk * 8 + part) * 256 + F.tid] = sum; }
        __syncthreads();
    }
    {
        const GAS int* pos = (const GAS int*)INP(F, 2);
        GAS float* rc = (GAS float*)(F.ws + WS_ROPEC); GAS float* rs = (GAS float*)(F.ws + WS_ROPES);
        const float invf = (float)exp2(-(double)(gtid & 31) * (13.287712379549449 / 32.0));
        int pv[8];
#pragma unroll
        for (int j = 0; j < 8; ++j) { const int idx = gtid + j * NT; pv[j] = (idx < MROWS * 32) ? pos[idx >> 5] : 0; }
#pragma unroll
        for (int j = 0; j < 8; ++j) { const int idx = gtid + j * NT;
            if (idx < MROWS * 32) {
                const float ang = (float)pv[j] * invf;
                const double rev = (double)ang * 0.15915494309189535; const float fr = (float)(rev - floor(rev));
                rc[idx] = __builtin_amdgcn_cosf(fr); rs[idx] = __builtin_amdgcn_sinf(fr); } }
        for (int idx = gtid + 8 * NT; idx < MROWS * 32; idx += NT) {
            const int row = idx >> 5;
            const float ang = (float)pos[row] * invf;
            const double rev = (double)ang * 0.15915494309189535; const float fr = (float)(rev - floor(rev));
            rc[idx] = __builtin_amdgcn_cosf(fr); rs[idx] = __builtin_amdgcn_sinf(fr);
        }
    }
    {
        GAS float* bp = (GAS float*)(F.ws + WS_BINP);
        for (int idx = gtid; idx < DEPTH * NPAD; idx += NT) { const int l = idx / NPAD, p = idx % NPAD; const int c = cmap_in(p); bp[idx] = (c >= 0) ? INP(F, 7)[(size_t)l * INW + c] : 0.f; }
    }
    {
        LAS float* scr = (LAS float*)(F.lds + F.wave * 16384);
        constexpr int I_IN = 16 * 160, I_UP = 8 * 32, I_O = 16 * 32, I_F1 = 16 * 128, I_F2 = 64 * 32, I_C1 = 32 * 8, I_C2 = 4 * 2, I_L = I_IN + 2 * I_UP + I_O + I_F1 + I_F2 + 2 * I_C1 + 2 * I_C2;
        auto desc = [&](int it) -> TrDesc {
            const int l = it / I_L; int r = it % I_L;
            GAS unsigned char* wl = F.ws + WS_W + (size_t)l * W_LAYER; GAS unsigned char* cw = F.ws + WS_CW;
            TrDesc d; d.mapped = false; d.kdst0 = 0;
            if (r < I_IN) { d.W = INP(F, 6) + (size_t)l * DM * INW; d.ldw = INW; d.nblk = 160; d.WT = (GAS bf16*)(wl + W_IN); d.ldt = DM; d.mapped = true; d.item = r; return d; } r -= I_IN;
            if (r < I_UP) { d.W = INP(F, 15) + (size_t)l * 512 * DM; d.ldw = DM; d.nblk = 32; d.WT = (GAS bf16*)(wl + W_UP); d.ldt = DM; d.item = r; return d; } r -= I_UP;
            if (r < I_UP) { d.W = INP(F, 16) + (size_t)l * 512 * DM; d.ldw = DM; d.nblk = 32; d.WT = (GAS bf16*)(wl + W_UP); d.ldt = DM; d.kdst0 = 512; d.item = r; return d; } r -= I_UP;
            if (r < I_O) { d.W = INP(F, 17) + (size_t)l * DM * DM; d.ldw = DM; d.nblk = 32; d.WT = (GAS bf16*)(wl + W_O); d.ldt = DM; d.item = r; return d; } r -= I_O;
            if (r < I_F1) { d.W = INP(F, 19) + (size_t)l * DM * DFF; d.ldw = DFF; d.nblk = 128; d.WT = (GAS bf16*)(wl + W_F1); d.ldt = DM; d.item = r; return d; } r -= I_F1;
            if (r < I_F2) { d.W = INP(F, 20) + (size_t)l * DFF * DM; d.ldw = DM; d.nblk = 32; d.WT = (GAS bf16*)(wl + W_F2); d.ldt = DFF; d.item = r; return d; } r -= I_F2;
            if (r < I_C1) { d.W = INP(F, 9) + (size_t)l * 2048 * 256; d.ldw = 256; d.nblk = 8; d.WT = (GAS bf16*)(cw + CW_W1T) + (size_t)(l * 2 + 0) * 256 * 2048; d.ldt = 2048; d.item = r; return d; } r -= I_C1;
            if (r < I_C1) { d.W = INP(F, 12) + (size_t)l * 2048 * 256; d.ldw = 256; d.nblk = 8; d.WT = (GAS bf16*)(cw + CW_W1T) + (size_t)(l * 2 + 1) * 256 * 2048; d.ldt = 2048; d.item = r; return d; } r -= I_C1;
            if (r < I_C2) { d.W = INP(F, 10) + (size_t)l * 256 * 64; d.ldw = 64; d.nblk = 2; d.WT = (GAS bf16*)(cw + CW_W2T) + (size_t)(l * 2 + 0) * 64 * 256; d.ldt = 256; d.item = r; return d; } r -= I_C2;
            d.W = INP(F, 13) + (size_t)l * 256 * 64; d.ldw = 64; d.nblk = 2; d.WT = (GAS bf16*)(cw + CW_W2T) + (size_t)(l * 2 + 1) * 64 * 256; d.ldt = 256; d.item = r; return d;
        };
        if (gw < DEPTH * I_L) {
            TrDesc dc = desc(gw); TrRegs tc; tr_load(dc, tc, F.lane);
            for (int it = gw; it < DEPTH * I_L; it += NGW) {
                const int nx = it + NGW; const bool more = nx < DEPTH * I_L;
                TrDesc dn = dc; TrRegs tn = tc;
                if (more) { dn = desc(nx); tr_load(dn, tn, F.lane); }
                tr_finish(dc, tc, scr, F.lane);
                dc = dn; tc = tn;
            }
        }
    }
}

__device__ __forceinline__ void norm_mod_phase(Frame& F, const GAS float* x32, const GAS bf16* xr, const GAS float* gvec, const GAS float* cond_l, int sh_chunk, int sc_chunk, GAS bf16* H) {
    const int gw = F.rk * NWAVES + F.wave, NGW = F.nl * NWAVES; const int R0 = F.b0 * SEQ, R1 = R0 + F.nb * SEQ;
    for (int r0 = R0 + gw * 16; r0 < R1; r0 += NGW * 16) {
        const int b = r0 / SEQ;
        f32x4 gc[4], sh[4];
#pragma unroll
        for (int q = 0; q < 4; ++q) { const int col = 512 * (q >> 1) + 8 * F.lane + 4 * (q & 1);
            const f32x4 gv = *(const GAS f32x4*)(gvec + col), sc = *(const GAS f32x4*)(cond_l + (size_t)b * NCOND + sc_chunk * DM + col);
            gc[q] = gv * (sc + 1.0f); sh[q] = *(const GAS f32x4*)(cond_l + (size_t)b * NCOND + sh_chunk * DM + col); }
        for (int r = 0; r < 16; ++r) {
            const int row = r0 + r;
            f32x4 v[4]; float s = 0.f;
            if (x32) {
#pragma unroll
                for (int q = 0; q < 4; ++q) v[q] = *(const GAS f32x4*)(x32 + (size_t)row * DM + 512 * (q >> 1) + 8 * F.lane + 4 * (q & 1));
            } else {
#pragma unroll
                for (int j = 0; j < 2; ++j) { const v4u p = *(const GAS v4u*)(xr + (size_t)row * XRP + 512 * j + 8 * F.lane);
                    v[2 * j] = (f32x4){bf_lo(p.x), bf_hi(p.x), bf_lo(p.y), bf_hi(p.y)}; v[2 * j + 1] = (f32x4){bf_lo(p.z), bf_hi(p.z), bf_lo(p.w), bf_hi(p.w)}; }
            }
#pragma unroll
            for (int q = 0; q < 4; ++q) s += (v[q].x * v[q].x + v[q].y * v[q].y) + (v[q].z * v[q].z + v[q].w * v[q].w);
            const float rs = 1.0f / sqrtf(wave_sum(s) * (1.0f / DM) + EPS);
#pragma unroll
            for (int j = 0; j < 2; ++j) { const f32x4 y0 = v[2 * j] * rs * gc[2 * j] + sh[2 * j], y1 = v[2 * j + 1] * rs * gc[2 * j + 1] + sh[2 * j + 1];
                v4u o; o.x = pk2(y0.x, y0.y); o.y = pk2(y0.z, y0.w); o.z = pk2(y1.x, y1.y); o.w = pk2(y1.z, y1.w);
                *(GAS v4u*)(H + (size_t)row * DM + 512 * j + 8 * F.lane) = o; }
        }
    }
}
__device__ __forceinline__ void final_norm_phase(Frame& F, const GAS bf16* xr, const GAS float* gvec, GAS float* out) {
    const int gw = F.rk * NWAVES + F.wave, NGW = F.nl * NWAVES; const int R0 = F.b0 * SEQ, R1 = R0 + F.nb * SEQ;
    f32x4 gc[4];
#pragma unroll
    for (int q = 0; q < 4; ++q) gc[q] = *(const GAS f32x4*)(gvec + 512 * (q >> 1) + 8 * F.lane + 4 * (q & 1));
    for (int row = R0 + gw; row < R1; row += NGW) {
        f32x4 v[4]; float s = 0.f;
#pragma unroll
        for (int j = 0; j < 2; ++j) { const v4u p = *(const GAS v4u*)(xr + (size_t)row * XRP + 512 * j + 8 * F.lane);
            v[2 * j] = (f32x4){bf_lo(p.x), bf_hi(p.x), bf_lo(p.y), bf_hi(p.y)}; v[2 * j + 1] = (f32x4){bf_lo(p.z), bf_hi(p.z), bf_lo(p.w), bf_hi(p.w)}; }
#pragma unroll
        for (int q = 0; q < 4; ++q) s += (v[q].x * v[q].x + v[q].y * v[q].y) + (v[q].z * v[q].z + v[q].w * v[q].w);
        const float rs = 1.0f / sqrtf(wave_sum(s) * (1.0f / DM) + EPS);
        asm volatile("s_waitcnt vmcnt(0)" ::: "memory");
#pragma unroll
        for (int q = 0; q < 4; ++q) *(GAS f32x4*)(out + (size_t)row * DM + 512 * (q >> 1) + 8 * F.lane + 4 * (q & 1)) = v[q] * rs * gc[q];
    }
}
__device__ __forceinline__ void unpack8(const v4u u, float (&f)[8]) { f[0] = bf_lo(u.x); f[1] = bf_hi(u.x); f[2] = bf_lo(u.y); f[3] = bf_hi(u.y); f[4] = bf_lo(u.z); f[5] = bf_hi(u.z); f[6] = bf_lo(u.w); f[7] = bf_hi(u.w); }
__device__ __forceinline__ void conv_phase(Frame& F, const GAS bf16* ZC_, const GAS float* cw  , GAS bf16* CV  , int blk, int nblk) {
    const int gw = blk * NWAVES + F.wave, NGW = nblk * NWAVES; const int c8 = 8 * F.lane; const int R0 = F.b0 * SEQ, R1 = R0 + F.nb * SEQ;
    float w0[8], w1[8], w2[8];
#pragma unroll
    for (int i = 0; i < 8; ++i) { w0[i] = cw[c8 + i]; w1[i] = cw[512 + c8 + i]; w2[i] = cw[1024 + c8 + i]; }
    const GAS bf16* ZCb = ZC_;
    for (int r0 = R0 + gw * 16; r0 < R1; r0 += NGW * 16) {
        const int t0 = r0 % SEQ; const GAS bf16* ZC = ZCb + (size_t)(r0 / SEQ) * XE_ZC;
        float vm2[8], vm1[8];
#pragma unroll
        for (int i = 0; i < 8; ++i) { vm2[i] = 0.f; vm1[i] = 0.f; }
        if (t0 >= 2) {
            float a[8], b[8];
            unpack8(*(const GAS v4u*)(ZC + (size_t)(r0 - 2) * 1536 + 512 + c8), a); unpack8(*(const GAS v4u*)(ZC + (size_t)(r0 - 2) * 1536 + 1024 + c8), b);
#pragma unroll
            for (int i = 0; i < 8; ++i) vm2[i] = a[i] * b[i];
            unpack8(*(const GAS v4u*)(ZC + (size_t)(r0 - 1) * 1536 + 512 + c8), a); unpack8(*(const GAS v4u*)(ZC + (size_t)(r0 - 1) * 1536 + 1024 + c8), b);
#pragma unroll
            for (int i = 0; i < 8; ++i) vm1[i] = a[i] * b[i];
        }
#pragma unroll 1
        for (int r = 0; r < 16; r += 4) {
            v4u lg[4], la[4], lb[4];
#pragma unroll
            for (int q = 0; q < 4; ++q) { const size_t row = (size_t)(r0 + r + q);
                lg[q] = *(const GAS v4u*)(ZC + row * 1536 + c8); la[q] = *(const GAS v4u*)(ZC + row * 1536 + 512 + c8); lb[q] = *(const GAS v4u*)(ZC + row * 1536 + 1024 + c8); }
            asm volatile("" ::: "memory");
#pragma unroll
            for (int q = 0; q < 4; ++q) { const size_t row = (size_t)(r0 + r + q);
                float a[8], b[8], g[8], y[8];
                unpack8(lg[q], g); unpack8(la[q], a); unpack8(lb[q], b);
#pragma unroll
                for (int i = 0; i < 8; ++i) { const float v = a[i] * b[i]; y[i] = g[i] * (w0[i] * vm2[i] + w1[i] * vm1[i] + w2[i] * v); vm2[i] = vm1[i]; vm1[i] = v; }
                v4u o; o.x = pk2(y[0], y[1]); o.y = pk2(y[2], y[3]); o.z = pk2(y[4], y[5]); o.w = pk2(y[6], y[7]);
                *(GAS v4u*)(CV + row * 1024 + c8) = o; }
            asm volatile("" ::: "memory");
        }
    }
}
__device__ __forceinline__ void compress_phase(Frame& F, int l, const GAS bf16* KV, GAS bf16* KCMP, GAS bf16* VCMP) {
    const int gw = F.vcu * NWAVES + F.wave, NGW = F.G * NWAVES; const int lane = F.lane;
    for (int unit = gw; unit < 2 * BATCH * 2 * 16; unit += NGW) {
        const int cg = unit & 15, g = (unit >> 4) & 1, b = (unit >> 5) & 15, kind = unit >> 9, c0 = cg * 8;
        const GAS float* W1 = INP(F, kind ? 12 : 9) + (size_t)l * 2048 * 256;
        const GAS float* W2 = INP(F, kind ? 13 : 10) + (size_t)l * 256 * 64;
        const GAS float* pe = INP(F, kind ? 14 : 11) + (size_t)l * 32 * 64;
        const GAS bf16* src = KV + (size_t)b * SEQ * 768 + kind * 128 + g * 64 + lane;
        float acc[8][4];
#pragma unroll
        for (int r = 0; r < 8; ++r)
#pragma unroll
            for (int i = 0; i < 4; ++i) acc[r][i] = 0.f;
        for (int lq = 0; lq < 32; ++lq) {
            const float pev = pe[lq * 64 + lane];
            float xv[8];
#pragma unroll
            for (int r = 0; r < 8; ++r) { int tok = 16 * (c0 + r) + lq; tok = tok > SEQ - 1 ? SEQ - 1 : tok; xv[r] = bf2f(src[(size_t)tok * 768]) + pev; }
            const GAS float* w1p = W1 + (size_t)lq * 64 * 256 + 4 * lane;
#pragma unroll 4
            for (int d = 0; d < 64; ++d) {
                const f32x4 w4 = *(const GAS f32x4*)(w1p + (size_t)d * 256);
#pragma unroll
                for (int r = 0; r < 8; ++r) { const float x = rdlane(xv[r], d); acc[r][0] += x * w4[0]; acc[r][1] += x * w4[1]; acc[r][2] += x * w4[2]; acc[r][3] += x * w4[3]; }
            }
        }
#pragma unroll
        for (int r = 0; r < 8; ++r)
#pragma unroll
            for (int i = 0; i < 4; ++i) { const float a = acc[r][i]; acc[r][i] = a * sigmoidf_(a); }
        float o[8];
#pragma unroll
        for (int r = 0; r < 8; ++r) o[r] = 0.f;
        for (int jj = 0; jj < 64; ++jj) {
#pragma unroll
            for (int i = 0; i < 4; ++i) { const float w = W2[(size_t)(4 * jj + i) * 64 + lane];
#pragma unroll
                for (int r = 0; r < 8; ++r) o[r] += rdlane(acc[r][i], jj) * w; }
        }
        GAS bf16* dst = (kind ? VCMP : KCMP) + ((size_t)(b * 2 + g) * 128 + c0) * 64 + lane;
#pragma unroll
        for (int r = 0; r < 8; ++r) dst[r * 64] = (c0 + r < NCMP) ? (bf16)(pk2(o[r], 0.f) & 0xffffu) : (bf16)0;
    }
}

__device__ __forceinline__ void dot4(const GAS bf16* krow, const LAS float* qs, float (&s)[4]) {
#pragma unroll
    for (int h = 0; h < 4; ++h) s[h] = 0.f;
#pragma unroll
    for (int c8 = 0; c8 < 8; ++c8) {
        asm volatile("" ::: "memory");
        float k[8]; unpack8(*(const GAS v4u*)(krow + 8 * c8), k);
#pragma unroll
        for (int h = 0; h < 4; ++h) { const f32x4 qa = *(const LAS f32x4*)(qs + h * 64 + 8 * c8), qb = *(const LAS f32x4*)(qs + h * 64 + 8 * c8 + 4);
            s[h] += (k[0] * qa[0] + k[1] * qa[1]) + (k[2] * qa[2] + k[3] * qa[3]) + (k[4] * qb[0] + k[5] * qb[1]) + (k[6] * qb[2] + k[7] * qb[3]); }
    }
}
__device__ __forceinline__ void attn_tile(const GAS bf16* kbase, const GAS bf16* vbase, size_t pitch, int key0, bool valid, int jmax, const LAS float* qs, int lane, float (&m)[4], float (&l)[4], float (&o)[4]) {
    float s[4]; dot4(kbase + (size_t)(key0 + lane) * pitch, qs, s);
    float p[4];
#pragma unroll
    for (int h = 0; h < 4; ++h) {
        const float sv = valid ? s[h] : -INFINITY;
        const float mt = wave_max(sv), mn = fmaxf(m[h], mt);
        const float alpha = (m[h] == -INFINITY) ? 0.f : fast_exp2(m[h] - mn);
        p[h] = (valid && mn > -INFINITY) ? fast_exp2(sv - mn) : 0.f;
        l[h] = l[h] * alpha + wave_sum(p[h]); o[h] *= alpha; m[h] = mn;
    }
    for (int j = 0; j <= jmax; ++j) {
        const float v = bf2f(vbase[(size_t)(key0 + j) * pitch + lane]);
#pragma unroll
        for (int h = 0; h < 4; ++h) o[h] += rdlane(p[h], j) * v;
    }
}
__device__ __forceinline__ void attn_naive_phase(Frame& F, const GAS bf16* Q, const GAS bf16* KV, const GAS bf16* KCMP, const GAS bf16* VCMP, const GAS float* NG, GAS bf16* AO  ) {
    const int gw = F.vcu * NWAVES + F.wave, NGW = F.G * NWAVES; const int lane = F.lane;
    LAS float* qs = (LAS float*)(F.lds + F.wave * 2048);
    LAS float* ps = qs + 256;
    for (int unit = gw; unit < MROWS * 2; unit += NGW) {
        const int row = unit >> 1, g = unit & 1, b = row / SEQ, t = row % SEQ;
        asm volatile("" ::: "memory");
#pragma unroll
        for (int h = 0; h < 4; ++h) qs[h * 64 + lane] = bf2f(Q[(size_t)row * 512 + (g * 4 + h) * 64 + lane]);
        LDS_WAIT();
        float outv[4];
        float gate[3][4];
#pragma unroll
        for (int br = 0; br < 3; ++br)
#pragma unroll
            for (int h = 0; h < 4; ++h) gate[br][h] = sigmoidf_(NG[(size_t)row * 24 + br * 8 + g * 4 + h]);
        const int cmax = (t >= 31) ? ((t - 31) >> 4) : -1;
        const GAS bf16* kc = KCMP + (size_t)(b * 2 + g) * 128 * 64; const GAS bf16* vc = VCMP + (size_t)(b * 2 + g) * 128 * 64;
        float p0[4], p1[4];
        {
            float s0[4], s1[4];
            dot4(kc + (size_t)lane * 64, qs, s0); dot4(kc + (size_t)(64 + lane) * 64, qs, s1);
            const bool v0 = lane <= cmax, v1 = 64 + lane <= cmax;
#pragma unroll
            for (int h = 0; h < 4; ++h) {
                const float a = v0 ? s0[h] : -INFINITY, c = v1 ? s1[h] : -INFINITY;
                const float mx = wave_max(fmaxf(a, c));
                const float e0 = v0 ? fast_exp2(a - mx) : 0.f, e1 = v1 ? fast_exp2(c - mx) : 0.f;
                const float sum = wave_sum(e0 + e1); const float inv = (cmax >= 0) ? 1.0f / sum : 0.f;
                p0[h] = e0 * inv; p1[h] = e1 * inv;
            }
            float oc[4] = {0.f, 0.f, 0.f, 0.f};
            for (int c = 0; c <= cmax; ++c) {
                const float v = bf2f(vc[(size_t)c * 64 + lane]);
#pragma unroll
                for (int h = 0; h < 4; ++h) { const float pc = (c < 64) ? rdlane(p0[h], c & 63) : rdlane(p1[h], c & 63); oc[h] += pc * v; }
            }
#pragma unroll
            for (int h = 0; h < 4; ++h) outv[h] = gate[0][h] * oc[h];
        }
        unsigned selmask = 0u;
        {
            ps[lane] = (p0[0] + p0[1]) + (p0[2] + p0[3]); ps[64 + lane] = (p1[0] + p1[1]) + (p1[2] + p1[3]);
            LDS_WAIT();
            const int blk_t = t >> 6, n = lane;
            float imp = 0.f;
#pragma unroll
            for (int i = -1; i <= 3; ++i) { const int c = 4 * n + i; if (n < 32 && c >= 0 && c <= 126) imp += ps[c]; }
            const bool vn = (n < 32) && (n <= blk_t), forced = (n == 0) || (n == blk_t) || (n == blk_t - 1);
            float val = (n < 32) ? (vn ? imp + (forced ? 1e4f : 0.f) : -1.0f) : -INFINITY;
            for (int k = 0; k < 8; ++k) {
                const float mx = wave_max(val);
                const unsigned long long bal = __ballot(val == mx);
                const int idx = __ffsll((long long)bal) - 1;
                selmask |= 1u << idx;
                if (lane == idx) val = -INFINITY;
            }
            selmask = (unsigned)__builtin_amdgcn_readfirstlane((int)selmask);
        }
        const GAS bf16* kvb = KV + (size_t)b * SEQ * 768 + g * 64;
        {
            float m[4], l[4], o[4];
#pragma unroll
            for (int h = 0; h < 4; ++h) { m[h] = -INFINITY; l[h] = 0.f; o[h] = 0.f; }
            const int blk_t = t >> 6;
            for (int n = 0; n <= blk_t; ++n) {
                if (!((selmask >> n) & 1u)) continue;
                const int key0 = 64 * n; const bool valid = key0 + lane <= t; const int jmax = (t - key0) < 63 ? (t - key0) : 63;
                attn_tile(kvb + 256, kvb + 384, 768, key0, valid, jmax, qs, lane, m, l, o);
            }
#pragma unroll
            for (int h = 0; h < 4; ++h) outv[h] += gate[1][h] * o[h] / l[h];
        }
        {
            float m[4], l[4], o[4];
#pragma unroll
            for (int h = 0; h < 4; ++h) { m[h] = -INFINITY; l[h] = 0.f; o[h] = 0.f; }
            const int nlo = (t - 511) > 0 ? ((t - 511) >> 6) : 0;
            for (int n = t >> 6; n >= nlo; --n) {
                const int key0 = 64 * n; const int key = key0 + lane; const bool valid = (key <= t) && (key > t - 512); const int jmax = (t - key0) < 63 ? (t - key0) : 63;
                attn_tile(kvb + 512, kvb + 640, 768, key0, valid, jmax, qs, lane, m, l, o);
            }
#pragma unroll
            for (int h = 0; h < 4; ++h) outv[h] += gate[2][h] * o[h] / l[h];
        }
#pragma unroll
        for (int h = 0; h < 4; ++h) AO[(size_t)row * 1024 + (g * 4 + h) * 64 + lane] = (bf16)(pk2(outv[h], 0.f) & 0xffffu);
    }
}

typedef short bf16x8_t __attribute__((ext_vector_type(8)));
typedef short bf16x4_t __attribute__((ext_vector_type(4)));
typedef float f32x16 __attribute__((ext_vector_type(16)));
constexpr int AT_SLOT = 8192, AT_KRING = 0, AT_VRING = 4 * AT_SLOT;
typedef short at_s4 __attribute__((ext_vector_type(4)));
__device__ __forceinline__ void at_dma(const GAS unsigned char* gsrc, LAS unsigned char* dst) {
    unsigned keep; const unsigned ldsa = (unsigned)__builtin_amdgcn_readfirstlane((int)(unsigned)(__UINTPTR_TYPE__)dst);
    asm volatile("s_mov_b32 %0, m0\n\ts_mov_b32 m0, %2\n\ts_nop 0\n\tglobal_load_lds_dwordx4 %1, off\n\ts_mov_b32 m0, %0" : "=&s"(keep) : "v"(gsrc), "s"(ldsa) : "memory");
}
__device__ __forceinline__ void at_dma_tile(LAS unsigned char* ring, int slot, int w, const GAS unsigned char* kb, const GAS unsigned char* vb, unsigned koff, unsigned voff) {
    at_dma(kb + koff, ring + AT_KRING + slot * AT_SLOT + w * 1024);
    at_dma(vb + voff, ring + AT_VRING + slot * AT_SLOT + w * 1024);
}
#define AT_WAIT_BAR(N) asm volatile("s_waitcnt vmcnt(" #N ") lgkmcnt(0)\n\ts_barrier" ::: "memory")
__device__ __forceinline__ bf16x8_t at_vfrag(const LAS unsigned char* p) {
    const at_s4 lo = __builtin_bit_cast(at_s4, __builtin_amdgcn_ds_read_tr16_b64_v4i16((LAS at_s4*)p));
    const at_s4 hi = __builtin_bit_cast(at_s4, __builtin_amdgcn_ds_read_tr16_b64_v4i16((LAS at_s4*)(p + 512)));
    return __builtin_shufflevector(lo, hi, 0, 1, 2, 3, 4, 5, 6, 7);
}
__device__ __forceinline__ void at_qk(const LAS unsigned char* kslot, const LAS unsigned char* qp, int l31, int hi, f32x16 (&s)[2]) {
#pragma unroll
    for (int kh = 0; kh < 2; ++kh) {
        f32x16 acc = (f32x16){0.f, 0.f, 0.f, 0.f, 0.f, 0.f, 0.f, 0.f, 0.f, 0.f, 0.f, 0.f, 0.f, 0.f, 0.f, 0.f};
#pragma unroll
        for (int ks = 0; ks < 4; ++ks) {
            const bf16x8_t kf = *(const LAS bf16x8_t*)(kslot + (2 * ks + hi) * 1024 + (32 * kh + l31) * 16);
            acc = __builtin_amdgcn_mfma_f32_32x32x16_bf16(kf, *(const LAS bf16x8_t*)(qp + ks * 1024), acc, 0, 0, 0);
        }
        s[kh] = acc;
    }
}
__device__ __forceinline__ void at_pv(const LAS unsigned char* vslot, int vp0, const bf16x8_t (&pf)[2][2], f32x16 (&o)[2]) {
#pragma unroll
    for (int dh = 0; dh < 2; ++dh)
#pragma unroll
        for (int kh = 0; kh < 2; ++kh)
#pragma unroll
            for (int s2 = 0; s2 < 2; ++s2)
                o[dh] = __builtin_amdgcn_mfma_f32_32x32x16_bf16(at_vfrag(vslot + vp0 + dh * 4096 + (2 * kh + s2) * 1024), pf[kh][s2], o[dh], 0, 0, 0);
}
__device__ __forceinline__ void at_pack(const f32x16 (&p)[2], bf16x8_t (&pf)[2][2]) {
#pragma unroll
    for (int kh = 0; kh < 2; ++kh)
#pragma unroll
        for (int s2 = 0; s2 < 2; ++s2) {
            v4u w; w.x = pk2(p[kh][8 * s2 + 0], p[kh][8 * s2 + 1]); w.y = pk2(p[kh][8 * s2 + 2], p[kh][8 * s2 + 3]);
            w.z = pk2(p[kh][8 * s2 + 4], p[kh][8 * s2 + 5]); w.w = pk2(p[kh][8 * s2 + 6], p[kh][8 * s2 + 7]);
            pf[kh][s2] = __builtin_bit_cast(bf16x8_t, w);
        }
}
typedef unsigned at_u2 __attribute__((ext_vector_type(2)));
__device__ __forceinline__ float xhalf_max(float v) { const at_u2 r = __builtin_amdgcn_permlane32_swap(__float_as_uint(v), __float_as_uint(v), false, false); return fmaxf(__uint_as_float(r.x), __uint_as_float(r.y)); }
__device__ __forceinline__ float xhalf_sum(float v) { const at_u2 r = __builtin_amdgcn_permlane32_swap(__float_as_uint(v), __float_as_uint(v), false, false); return __uint_as_float(r.x) + __uint_as_float(r.y); }
__device__ __forceinline__ float xhalf(float v) { const at_u2 r = __builtin_amdgcn_permlane32_swap(__float_as_uint(v), __float_as_uint(v), false, false); const bool up = (__builtin_amdgcn_mbcnt_hi(~0u, __builtin_amdgcn_mbcnt_lo(~0u, 0u)) >= 32u); return __uint_as_float(up ? r.x : r.y); }
__device__ __forceinline__ float dpp_xor1(float v) { return __int_as_float(__builtin_amdgcn_mov_dpp(__float_as_int(v), 0xB1, 0xF, 0xF, true)); }
__device__ __forceinline__ float dpp_xor2(float v) { return __int_as_float(__builtin_amdgcn_mov_dpp(__float_as_int(v), 0x4E, 0xF, 0xF, true)); }
__device__ __forceinline__ int crow16(int r, int hi) { return (r & 3) + 8 * (r >> 2) + 4 * hi; }
constexpr float AT_THR = 8.0f;
constexpr int AT_OUT_OFF = 8 * AT_SLOT;
constexpr int AT_Q_OFF = AT_OUT_OFF + 8 * 4096;

struct AtUnitCtx { int qt, nitems, iq, l31, hi, tid, w, vp0; unsigned selmask; const GAS unsigned char* kvb; unsigned koff_kv, voff_kv; float gate1, gate2; };
__device__ __forceinline__ void at_item(const AtUnitCtx& c, int it, int& n, bool& is_win) { is_win = it > c.qt; n = is_win ? (c.qt - (it - c.qt - 1)) : it; }
__device__ __forceinline__ void at_step(const AtUnitCtx& c, LAS unsigned char* ring, LAS unsigned* outw, int it, int bcur, const LAS unsigned char* qp,
                                        f32x16 (&scur)[2], f32x16 (&snext)[2], float& m, float& l, f32x16 (&o)[2], int lane, f32x16& negm, float& mq) {
    const bool has3 = it + 3 < c.nitems;
    if (has3) { int n3; bool w3; at_item(c, it + 3, n3, w3); const GAS unsigned char* tb = c.kvb + (size_t)n3 * 98304 + (w3 ? 1024 : 512); at_dma_tile(ring, (it + 3) & 3, c.w, tb, tb + 256, c.koff_kv, c.voff_kv); }
    const LAS unsigned char* cur = ring + AT_VRING + (it & 3) * AT_SLOT; const LAS unsigned char* nxt = ring + AT_KRING + ((it + 1) & 3) * AT_SLOT;
    int n; bool is_win;
    at_item(c, it, n, is_win);
    const bool sel_here = is_win || ((c.selmask >> n) & 1u);
    const LAS unsigned char* kb = nxt + c.hi * 1024 + c.l31 * 16;
    const LAS unsigned char* vb = cur + c.vp0;
#define AT_KF(kh, ks) (*(const LAS bf16x8_t*)(kb + (ks) * 2048 + (kh) * 512))
#define AT_VF(dh, g) at_vfrag(vb + (dh) * 4096 + (g) * 1024)
    bf16x8_t kfa[4], kfb[4], vfa[4], vfb[4];
    float strow = 0.f;
    if (!is_win && !__any(sel_here)) {
#pragma unroll
        for (int g = 0; g < 4; ++g) { kfa[g] = AT_KF(0, g); kfb[g] = AT_KF(1, g); }
#pragma unroll
        for (int g = 0; g < 4; ++g) { const bf16x8_t qg = *(const LAS bf16x8_t*)(qp + g * 1024);
            snext[0] = __builtin_amdgcn_mfma_f32_32x32x16_bf16(kfa[g], qg, g == 0 ? negm : snext[0], 0, 0, 0);
            snext[1] = __builtin_amdgcn_mfma_f32_32x32x16_bf16(kfb[g], qg, g == 0 ? negm : snext[1], 0, 0, 0); }
    } else {
    kfa[0] = AT_KF(0, 0); kfb[0] = AT_KF(1, 0); vfa[0] = AT_VF(0, 0); vfb[0] = AT_VF(1, 0);
    const bool diag = (n == c.qt), lowedge = is_win && (n == c.qt - 8);
    if (diag || lowedge) {
        int iqv = c.iq; asm volatile("" : "+v"(iqv));
        const int jhi = (diag ? iqv : 63) - 4 * c.hi, jlo = (lowedge ? iqv : -1) - 4 * c.hi;
#pragma unroll
        for (int kh = 0; kh < 2; ++kh)
#pragma unroll
            for (int i = 0; i < 16; ++i) { const int j = 32 * kh + crow16(i, 0); const bool ok = (j <= jhi) && (j > jlo); scur[kh][i] = ok ? scur[kh][i] : -INFINITY; }
    }
    float mx = -INFINITY;
#pragma unroll
    for (int kh = 0; kh < 2; ++kh)
#pragma unroll
        for (int i = 0; i < 16; ++i) mx = fmaxf(mx, scur[kh][i]);
    mx = sel_here ? xhalf_max(mx) + mq : -INFINITY;
    if (__any(mx > m + AT_THR)) {
        const float mn = fmaxf(m, mx); const float alpha = fast_exp2(m - mn);
        l *= alpha; m = mn;
#pragma unroll
        for (int dh = 0; dh < 2; ++dh)
#pragma unroll
            for (int i = 0; i < 16; ++i) o[dh][i] *= alpha;
        const float dm = sel_here ? (mn - mq) : 0.f;
#pragma unroll
        for (int kh = 0; kh < 2; ++kh)
#pragma unroll
            for (int i = 0; i < 16; ++i) scur[kh][i] -= dm;
        const float nm = (mn == -INFINITY) ? 0.f : -mn;
#pragma unroll
        for (int i = 0; i < 16; ++i) negm[i] = nm;
        asm volatile("" : "+v"(negm));
    }
    const unsigned keep = (is_win || sel_here) ? 0xffffffffu : 0u;
    float sumg[4];
#pragma unroll
    for (int g = 0; g < 4; ++g) {
        if (g < 3) { kfa[g + 1] = AT_KF(0, g + 1); kfb[g + 1] = AT_KF(1, g + 1); vfa[g + 1] = AT_VF(0, g + 1); vfb[g + 1] = AT_VF(1, g + 1); }
        const int kh = g >> 1, s2 = g & 1;
        float e[8];
#pragma unroll
        for (int j = 0; j < 8; ++j) e[j] = fast_exp2(scur[kh][8 * s2 + j]);
        sumg[g] = ((e[0] + e[1]) + (e[2] + e[3])) + ((e[4] + e[5]) + (e[6] + e[7]));
        v4u w; w.x = pk2(e[0], e[1]); w.y = pk2(e[2], e[3]); w.z = pk2(e[4], e[5]); w.w = pk2(e[6], e[7]);
        if (!is_win) { w.x &= keep; w.y &= keep; w.z &= keep; w.w &= keep; }
        const bf16x8_t pfg = __builtin_bit_cast(bf16x8_t, w);
        const bf16x8_t qg = *(const LAS bf16x8_t*)(qp + g * 1024);
        snext[0] = __builtin_amdgcn_mfma_f32_32x32x16_bf16(kfa[g], qg, g == 0 ? negm : snext[0], 0, 0, 0);
        snext[1] = __builtin_amdgcn_mfma_f32_32x32x16_bf16(kfb[g], qg, g == 0 ? negm : snext[1], 0, 0, 0);
        o[0] = __builtin_amdgcn_mfma_f32_32x32x16_bf16(vfa[g], pfg, o[0], 0, 0, 0);
        o[1] = __builtin_amdgcn_mfma_f32_32x32x16_bf16(vfb[g], pfg, o[1], 0, 0, 0);
    }
    { const float st = (sumg[0] + sumg[1]) + (sumg[2] + sumg[3]); strow = (is_win || sel_here) ? st : 0.f; }
    }
#undef AT_KF
#undef AT_VF
    l += strow;
    mq = -negm[0];
    if (it == c.qt || it == c.nitems - 1) {
        const float lt = xhalf_sum(l); const float sc = ((it == c.qt) ? c.gate1 : c.gate2) * __builtin_amdgcn_rcpf(lt);
        unsigned t[16];
#pragma unroll
        for (int i = 0; i < 16; ++i) t[i] = outw[i * 64 + lane];
#pragma unroll
        for (int dh = 0; dh < 2; ++dh)
#pragma unroll
            for (int pr = 0; pr < 8; ++pr) { const unsigned pv = t[dh * 8 + pr];
                outw[(dh * 8 + pr) * 64 + lane] = pk2(bf_lo(pv) + sc * o[dh][2 * pr], bf_hi(pv) + sc * o[dh][2 * pr + 1]); o[dh][2 * pr] = 0.f; o[dh][2 * pr + 1] = 0.f; }
        m = -INFINITY; l = 0.f;
    }
    if (has3) AT_WAIT_BAR(2); else AT_WAIT_BAR(0);
}

__device__ __forceinline__ void attn_unit(Frame& F, int b, int g, int qt, const GAS bf16* Q, const GAS bf16* KV, const GAS bf16* KCMP, const GAS bf16* VCMP, const GAS float* NG, GAS bf16* AO) {
    int tid_ = F.tid; asm volatile("" : "+v"(tid_));
    const int tid = tid_, lane = tid & 63, w = F.wave, l31 = lane & 31, hi = lane >> 5;
    const int iq = 8 * w + (l31 >> 2), head = l31 & 3;
    const int t = 64 * qt + iq; const size_t row = (size_t)b * SEQ + t;
    LAS unsigned char* ring = F.lds;
    LAS unsigned* outw = (LAS unsigned*)(F.lds + AT_OUT_OFF + w * 4096);
    LAS unsigned char* qp = F.lds + AT_Q_OFF + w * 4096 + lane * 16;
    const unsigned vrow = 16u * (unsigned)(w & 3) + (unsigned)(lane >> 2), vcol = (unsigned)(w >> 2) * 64u + (unsigned)(lane & 3) * 16u;
    const unsigned koff_kv = (unsigned)lane * 1536u + 16u * (unsigned)w, voff_kv = vrow * 1536u + vcol;
    const unsigned koff_c = (unsigned)lane * 128u + 16u * (unsigned)w, voff_c = vrow * 128u + vcol;
    const int vp0 = ((lane >> 4) & 1) * 32 + (lane & 3) * 8 + (4 * hi + ((lane & 15) >> 2)) * 64;
    const GAS unsigned char* kc = (const GAS unsigned char*)(KCMP + (size_t)(b * 2 + g) * 128 * 64); const GAS unsigned char* vc = (const GAS unsigned char*)(VCMP + (size_t)(b * 2 + g) * 128 * 64);
    const GAS unsigned char* kvb = (const GAS unsigned char*)(KV + (size_t)b * SEQ * 768 + g * 64);
    const bool two_cmp = (4 * qt + 2) >= 64;
    const int nwin = (qt < 8) ? qt + 1 : 9;
    AtUnitCtx c; c.qt = qt; c.nitems = qt + 1 + nwin; c.iq = iq; c.l31 = l31; c.hi = hi; c.tid = tid; c.w = w; c.vp0 = vp0; c.kvb = kvb; c.koff_kv = koff_kv; c.voff_kv = voff_kv;
    at_dma_tile(ring, 2, w, kc, vc, koff_c, voff_c);
    if (two_cmp) at_dma_tile(ring, 3, w, kc + 8192, vc + 8192, koff_c, voff_c);
    at_dma_tile(ring, 0, w, kvb + 512, kvb + 768, koff_kv, voff_kv);
    { int n1; bool w1; at_item(c, 1, n1, w1); const GAS unsigned char* tb = kvb + (size_t)n1 * 98304 + (w1 ? 1024 : 512); at_dma_tile(ring, 1, w, tb, tb + 256, koff_kv, voff_kv); }
#pragma unroll
    for (int ks = 0; ks < 4; ++ks) *(LAS v4u*)(qp + ks * 1024) = *(const GAS v4u*)(Q + row * 512 + (g * 4 + head) * 64 + 16 * ks + 8 * hi);
    float gate[3];
#pragma unroll
    for (int br = 0; br < 3; ++br) gate[br] = sigmoidf_(NG[row * 24 + br * 8 + g * 4 + head]);
    asm volatile("" : "+v"(gate[0]), "+v"(gate[1]), "+v"(gate[2]));
    c.gate1 = gate[1]; c.gate2 = gate[2];
    AT_WAIT_BAR(0);
    {
        const int cmax = (t >= 31) ? ((t - 31) >> 4) : -1; const int cadj = cmax - 4 * hi;
        f32x16 s0[2], s1[2];
        at_qk(ring + AT_KRING + 2 * AT_SLOT, qp, l31, hi, s0);
        if (two_cmp) at_qk(ring + AT_KRING + 3 * AT_SLOT, qp, l31, hi, s1);
        else {
#pragma unroll
            for (int kh = 0; kh < 2; ++kh)
#pragma unroll
                for (int i = 0; i < 16; ++i) s1[kh][i] = -INFINITY;
        }
        float mx = -INFINITY;
#pragma unroll
        for (int kh = 0; kh < 2; ++kh)
#pragma unroll
            for (int i = 0; i < 16; ++i) {
                const int c0 = 32 * kh + crow16(i, 0);
                s0[kh][i] = (c0 <= cadj) ? s0[kh][i] : -INFINITY; s1[kh][i] = (64 + c0 <= cadj) ? s1[kh][i] : -INFINITY;
                mx = fmaxf(mx, fmaxf(s0[kh][i], s1[kh][i]));
            }
        mx = xhalf_max(mx);
        const float msafe = (mx == -INFINITY) ? 0.f : mx;
        float sum = 0.f;
#pragma unroll
        for (int kh = 0; kh < 2; ++kh)
#pragma unroll
            for (int i = 0; i < 16; ++i) { const float e0 = fast_exp2(s0[kh][i] - msafe), e1 = fast_exp2(s1[kh][i] - msafe); s0[kh][i] = e0; s1[kh][i] = e1; sum += e0 + e1; }
        sum = xhalf_sum(sum);
        const float inv = (sum > 0.f) ? 1.0f / sum : 0.f;
#pragma unroll
        for (int kh = 0; kh < 2; ++kh)
#pragma unroll
            for (int i = 0; i < 16; ++i) { s0[kh][i] *= inv; s1[kh][i] *= inv; }
        float G[16], L[16];
#pragma unroll
        for (int kh = 0; kh < 2; ++kh)
#pragma unroll
            for (int rq = 0; rq < 4; ++rq) {
                G[4 * kh + rq] = (s0[kh][4 * rq] + s0[kh][4 * rq + 1]) + (s0[kh][4 * rq + 2] + s0[kh][4 * rq + 3]); L[4 * kh + rq] = s0[kh][4 * rq + 3];
                G[8 + 4 * kh + rq] = (s1[kh][4 * rq] + s1[kh][4 * rq + 1]) + (s1[kh][4 * rq + 2] + s1[kh][4 * rq + 3]); L[8 + 4 * kh + rq] = s1[kh][4 * rq + 3];
            }
        {
            f32x16 oc[2];
#pragma unroll
            for (int dh = 0; dh < 2; ++dh)
#pragma unroll
                for (int i = 0; i < 16; ++i) oc[dh][i] = 0.f;
            bf16x8_t pf[2][2];
            at_pack(s0, pf); at_pv(ring + AT_VRING + 2 * AT_SLOT, vp0, pf, oc);
            if (two_cmp) { at_pack(s1, pf); at_pv(ring + AT_VRING + 3 * AT_SLOT, vp0, pf, oc); }
#pragma unroll
            for (int dh = 0; dh < 2; ++dh)
#pragma unroll
                for (int pr = 0; pr < 8; ++pr) outw[(dh * 8 + pr) * 64 + lane] = pk2(gate[0] * oc[dh][2 * pr], gate[0] * oc[dh][2 * pr + 1]);
        }
        unsigned selmask;
        if (qt < 8) selmask = (2u << qt) - 1u;
        else {
#pragma unroll
            for (int i = 0; i < 16; ++i) { G[i] += dpp_xor1(G[i]); G[i] += dpp_xor2(G[i]); L[i] += dpp_xor1(L[i]); L[i] += dpp_xor2(L[i]); }
#pragma unroll
            for (int i = 0; i < 16; ++i) L[i] = xhalf(L[i]);
#pragma unroll
            for (int i = 15; i >= 0; --i) { const float prev = (i > 0) ? L[i - 1] : 0.f; G[i] = G[i] + (hi ? L[i] : prev); }
            {
                const int nlim = qt - 1, hq = l31 & 3;
                const float a0 = (hq & 1) ? G[4] : G[0], a1 = (hq & 1) ? G[5] : G[1], a2 = (hq & 1) ? G[6] : G[2], a3 = (hq & 1) ? G[7] : G[3];
                const float b0 = (hq & 1) ? G[12] : G[8], b1 = (hq & 1) ? G[13] : G[9], b2 = (hq & 1) ? G[14] : G[10], b3 = (hq & 1) ? G[15] : G[11];
                const int n0 = 8 * hq + hi, n1 = n0 + 2, n2 = n0 + 4, n3 = n0 + 6;
                float c0 = (hq & 2) ? b0 : a0, c1 = (hq & 2) ? b1 : a1, c2 = (hq & 2) ? b2 : a2, c3 = (hq & 2) ? b3 : a3;
                c0 = (n0 >= 1 && n0 < nlim) ? c0 : -INFINITY; c1 = (n1 < nlim) ? c1 : -INFINITY; c2 = (n2 < nlim) ? c2 : -INFINITY; c3 = (n3 < nlim) ? c3 : -INFINITY;
                selmask = 1u | (1u << qt) | (1u << (qt - 1));
#pragma unroll
                for (int k = 0; k < 5; ++k) {
                    float bv = fmaxf(fmaxf(c0, c1), fmaxf(c2, c3));
                    bv = fmaxf(bv, dpp_xor1(bv)); bv = fmaxf(bv, dpp_xor2(bv)); bv = xhalf_max(bv);
                    const bool fin = bv > -INFINITY;
                    int li = 99;
                    li = (c3 == bv && fin) ? n3 : li; li = (c2 == bv && fin) ? n2 : li; li = (c1 == bv && fin) ? n1 : li; li = (c0 == bv && fin) ? n0 : li;
                    { const int o1 = __float_as_int(dpp_xor1(__int_as_float(li))); li = (o1 < li) ? o1 : li; }
                    { const int o2 = __float_as_int(dpp_xor2(__int_as_float(li))); li = (o2 < li) ? o2 : li; }
                    { const int o3 = __float_as_int(xhalf(__int_as_float(li))); li = (o3 < li) ? o3 : li; }
                    selmask |= (li < 32) ? (1u << li) : 0u;
                    c0 = (n0 == li) ? -INFINITY : c0; c1 = (n1 == li) ? -INFINITY : c1; c2 = (n2 == li) ? -INFINITY : c2; c3 = (n3 == li) ? -INFINITY : c3;
                }
            }
        }
        c.selmask = selmask;
    }
    asm volatile("s_waitcnt lgkmcnt(0)\n\ts_barrier" ::: "memory");
    if (c.nitems > 2) { int n2; bool w2; at_item(c, 2, n2, w2); const GAS unsigned char* tb = kvb + (size_t)n2 * 98304 + (w2 ? 1024 : 512); at_dma_tile(ring, 2, w, tb, tb + 256, koff_kv, voff_kv);
        AT_WAIT_BAR(2); }
    else AT_WAIT_BAR(0);
    float m = -INFINITY, l = 0.f, mq = 0.f;
    f32x16 negm;
#pragma unroll
    for (int i = 0; i < 16; ++i) negm[i] = 0.f;
    f32x16 o[2], sa[2], sb[2];
#pragma unroll
    for (int dh = 0; dh < 2; ++dh)
#pragma unroll
        for (int i = 0; i < 16; ++i) o[dh][i] = 0.f;
    at_qk(ring + AT_KRING, qp, l31, hi, sa);
    for (int it = 0; it < c.nitems; it += 2) {
        at_step(c, ring, outw, it, 0, qp, sa, sb, m, l, o, lane, negm, mq);
        if (it + 1 < c.nitems) at_step(c, ring, outw, it + 1, 0, qp, sb, sa, m, l, o, lane, negm, mq);
    }
    GAS bf16* dst = AO + row * 1024 + (g * 4 + head) * 64;
#pragma unroll
    for (int dh = 0; dh < 2; ++dh)
#pragma unroll
        for (int k2 = 0; k2 < 2; ++k2) {
            const int rq = hi + 2 * k2;
            const LAS unsigned* p = outw + (dh * 8 + 2 * rq) * 64 + l31;
            v4u wv; wv.x = p[0]; wv.y = p[64]; wv.z = p[32]; wv.w = p[96];
            *(GAS v4u*)(dst + 32 * dh + 8 * rq) = wv;
        }
}
__device__ __forceinline__ void attn_mfma_phase(Frame& F, const GAS bf16* Q, const GAS bf16* KV, const GAS bf16* KCMP, const GAS bf16* VCMP, const GAS float* NG, GAS bf16* AO  ) {
    int task = F.rk;
#pragma unroll 1
    for (; task < F.nb * 16; task += F.nl) {
        const int slot = task & 7, g = (task >> 3) & 1, b = F.b0 + (task >> 4);
        const unsigned pk = slot == 0 ? 45883u : slot == 1 ? 245269u : slot == 2 ? 10079u : slot == 3 ? 172606u : slot == 4 ? 77469u : slot == 5 ? 211542u : slot == 6 ? 142072u : 112252u;
#pragma unroll 1
        for (int k = 0; k < 4; ++k) attn_unit(F, b, g, (int)((pk >> (5 * k)) & 31u), Q + (size_t)b * XE_Q, KV, KCMP, VCMP, NG, AO);
    }
    __syncthreads();
}

#ifndef MK_SINGLE
#define MK_SINGLE 1
#endif
constexpr int NPL = 10, NPHASES = 2 + DEPTH * NPL;
struct Args { const float* in[22]; float* out; unsigned char* ws; int ph_lo, ph_hi; };
__global__ void __launch_bounds__(NWAVES * 64, 2) fwd(Args args) {
    extern __shared__ __attribute__((aligned(16))) unsigned char lds[];
    Frame F0;
    F0.lds = (LAS unsigned char*)lds;
    F0.tid = threadIdx.x; F0.lane = F0.tid & 63; F0.wave = __builtin_amdgcn_readfirstlane(F0.tid >> 6);
    F0.G = gridDim.x; { const int bx = blockIdx.x; F0.vcu = (F0.G % 8 == 0) ? (bx % 8) * (F0.G / 8) + bx / 8 : bx; }
    F0.out = (GAS float*)args.out; F0.ws = (GAS unsigned char*)args.ws;
    for (int u = F0.tid; u < (LDS_BYTES - LDSCTL_OFF) / 4; u += NWAVES * 64) ((LAS unsigned*)(F0.lds + LDSCTL_OFF))[u] = 0u;
    __syncthreads();
    if (F0.tid < 22) ((LAS unsigned long long*)(F0.lds + PTR_OFF))[F0.tid] = (unsigned long long)args.in[F0.tid];
    __syncthreads();
#if MK_SINGLE
    constexpr int lo = 0, hi = NPHASES;
#else
    const int lo = args.ph_lo, hi = args.ph_hi;
#endif
    XcdBarrier bar; bar.bar = (GAS unsigned*)(F0.ws + WS_CTL) + CW_BAR; bar.x = 0; bar.st = nullptr;
    if (hi - lo > 1) bar = xcd_barrier_post((GAS unsigned*)(F0.ws + WS_CTL) + CW_BAR, (volatile LAS unsigned*)(F0.lds + MISC_OFF) + 8, F0.tid);
#define IN(k) (lo <= (k) && (k) < hi)
#define SEAM(k) do { if (IN((k) + 1)) { if ((k) == 0) xcd_barrier(bar, F0.wave); else dom_barrier(bar, F0.wave); } } while (0)

    if (IN(0)) { Frame F = F0; asm volatile("" : "+s"(F.wave), "+s"(F.vcu)); { unsigned ones_ = ~0u; asm volatile("" : "+s"(ones_)); F.lane = (int)__builtin_amdgcn_mbcnt_hi(ones_, __builtin_amdgcn_mbcnt_lo(ones_, 0u)); } F.tid = (F.wave << 6) | F.lane; asm volatile("" : "+v"(F.tid), "+v"(F.lane)); p0_prologue(F);
#if defined(REP_PHASE) && REP_PHASE == 100
        __syncthreads(); p0_prologue(F);
#endif
        SEAM(0); }

#define OPQ() Frame F = F0; asm volatile("" : "+s"(F.wave), "+s"(F.vcu)); { unsigned ones_ = ~0u; asm volatile("" : "+s"(ones_)); F.lane = (int)__builtin_amdgcn_mbcnt_hi(ones_, __builtin_amdgcn_mbcnt_lo(ones_, 0u)); } F.tid = (F.wave << 6) | F.lane; asm volatile("" : "+v"(F.tid), "+v"(F.lane)); GAS unsigned char* ws = F.ws; GAS float* XR = F.out; asm volatile("" : "+s"(ws), "+s"(XR)); dom_load(F); \
    GAS bf16* H = (GAS bf16*)(ws + WS_H); GAS bf16* ZC = (GAS bf16*)(ws + WS_ZC); GAS bf16* Qb = (GAS bf16*)(ws + WS_Q); GAS bf16* KV = (GAS bf16*)(ws + WS_KV); GAS bf16* MG = (GAS bf16*)(ws + WS_MG); \
    GAS float* NG = (GAS float*)(ws + WS_NG); GAS bf16* KCMP = (GAS bf16*)(ws + WS_KCMP); GAS bf16* VCMP = (GAS bf16*)(ws + WS_VCMP); GAS bf16* CVAO = (GAS bf16*)(ws + WS_CVAO); GAS bf16* U = (GAS bf16*)(ws + WS_U); GAS bf16* A1 = (GAS bf16*)(ws + WS_A1); \
    const GAS float* cond_l = (const GAS float*)(ws + WS_COND) + (size_t)l * BATCH * NCOND; GAS unsigned char* wl = ws + WS_W + (size_t)l * W_LAYER; \
    (void)H; (void)ZC; (void)Qb; (void)KV; (void)MG; (void)NG; (void)KCMP; (void)VCMP; (void)CVAO; (void)U; (void)A1; (void)cond_l; (void)wl; (void)XR
    for (int l = 0; l < DEPTH; ++l) {
        const int pb = 1 + l * NPL;
        if (!(lo < pb + NPL && pb < hi)) continue;
        if (IN(pb + 0)) { OPQ(); const GAS float* x32 = (l == 0) ? INP(F, 0) : (const GAS float*)0; norm_mod_phase(F, x32, (const GAS bf16*)XR, INP(F, 5) + (size_t)l * DM, cond_l, 0, 1, H);
#if defined(REP_PHASE) && REP_PHASE == 0
            norm_mod_phase(F, x32, (const GAS bf16*)XR, INP(F, 5) + (size_t)l * DM, cond_l, 0, 1, H);
#endif
            SEAM(pb + 0); }
        if (IN(pb + 1)) { OPQ();
            pg8::Gemm g{H, (const GAS bf16*)(wl + W_IN), MROWS, NPAD, DM, DM, DM}; pg8::StaticOrder S; S.init(F.nb * (SEQ / 256), NPAD, F.nl, F.rk, F.b0 * (SEQ / 256));
            pg8::EpiIn E{ws, (const GAS float*)(ws + WS_BINP) + (size_t)l * NPAD};
            pg8::gemm_phase<pg8::EpiIn, pg8::StaticOrder, true, true>(F.lds, g, S, E, F.wave);
#if defined(REP_PHASE) && REP_PHASE == 1
            __syncthreads(); pg8::gemm_phase<pg8::EpiIn, pg8::StaticOrder, true, true>(F.lds, g, S, E, F.wave);
#endif
            SEAM(pb + 1);
        }
        if (IN(pb + 2)) { OPQ();
#ifdef CMP_NAIVE
            static_assert(false, "CMP_NAIVE is not supported in the domain build");
#else
            const int ncmp = 4 * F.nb;
#pragma unroll 1
            for (int cu = F.rk; cu < ncmp; cu += F.nl) {
                const int kh = cu & 1, kind = (cu >> 1) & 1, cb = F.b0 + (cu >> 2);
                GAS unsigned char* cw = ws + WS_CW;
                GAS unsigned* flag = (GAS unsigned*)(ws + WS_CTL) + 8192 + ((l * BATCH + cb) * 2 + kind) * 16;
                GAS unsigned char* part = (GAS unsigned char*)XR + ((size_t)cb * SEQ + kind * 256) * 4096 + 2048;
                const GAS bf16* W1 = (const GAS bf16*)(cw + CW_W1T) + (size_t)(l * 2 + kind) * 256 * 2048 + kh * (14 * 64);
                pg8::Gemm g{KV + kind * 128 + kh * 14 * 768, W1, 4096, 256, kh ? 18 * 64 : 14 * 64, 16 * 768, 2048, (size_t)1536, (size_t)128, (size_t)SEQ * 768 * 2};
                if (kh == 0) {
                    pg8::OneUnitSig S{true, cb, flag};
                    pg8::EpiCmpPart E{part};
                    pg8::gemm_phase<pg8::EpiCmpPart, pg8::OneUnitSig, false, true>(F.lds, g, S, E, F.wave);
                } else {
                    pg8::OneUnit S{true, cb};
                    pg8::EpiCmp E{(const GAS float*)(cw + CW_B1) + (l * 2 + kind) * 8 * 256, (const GAS bf16*)(cw + CW_W2T) + (size_t)(l * 2 + kind) * 64 * 256, kind ? VCMP : KCMP, part, flag};
                    pg8::gemm_phase<pg8::EpiCmp, pg8::OneUnit, false, true>(F.lds, g, S, E, F.wave);
                }
                __syncthreads();
            }
            if (F.nl > ncmp) { if (F.rk >= ncmp) conv_phase(F, ZC, INP(F, 8) + (size_t)l * 3 * 512, CVAO, F.rk - ncmp, F.nl - ncmp); }
            else conv_phase(F, ZC, INP(F, 8) + (size_t)l * 3 * 512, CVAO, F.rk, F.nl);
#endif
            SEAM(pb + 2); }
        if (IN(pb + 3)) { OPQ();
#ifdef ATTN_NAIVE
            attn_naive_phase(F, Qb, KV, KCMP, VCMP, NG, CVAO + 512); __syncthreads();
#else
            attn_mfma_phase(F, Qb, KV, KCMP, VCMP, NG, CVAO + 512);
#if defined(REP_PHASE) && REP_PHASE == 3
            attn_mfma_phase(F, Qb, KV, KCMP, VCMP, NG, CVAO + 512);
#endif
#endif
            SEAM(pb + 3); }
        if (IN(pb + 4)) { OPQ();
            pg8::Gemm g{CVAO, (const GAS bf16*)(wl + W_UP), MROWS, DM, DM, DM, DM}; pg8::StaticOrder S; S.init(F.nb * (SEQ / 256), DM, F.nl, F.rk, F.b0 * (SEQ / 256));
            pg8::EpiUpM E{U, MG};
            pg8::gemm_phase<pg8::EpiUpM, pg8::StaticOrder, true, true>(F.lds, g, S, E, F.wave);
            SEAM(pb + 5);
        }
        if (IN(pb + 6)) { OPQ(); const GAS float* xin = (l == 0) ? INP(F, 0) : (const GAS float*)0;
            pg8::Gemm g{U, (const GAS bf16*)(wl + W_O), MROWS, DM, DM, DM, DM, 0, 0, 0, XE_U * 2}; pg8::StaticOrder S; S.init(F.nb * (SEQ / 256), DM, F.nl, F.rk, F.b0 * (SEQ / 256));
            pg8::EpiRes E{xin, (GAS bf16*)XR, cond_l + 2 * DM};
            pg8::gemm_phase<pg8::EpiRes, pg8::StaticOrder, true, true>(F.lds, g, S, E, F.wave);
            SEAM(pb + 6);
        }
        if (IN(pb + 7)) { OPQ(); norm_mod_phase(F, (const GAS float*)0, (const GAS bf16*)XR, INP(F, 18) + (size_t)l * DM, cond_l, 3, 4, H);
#if defined(REP_PHASE) && REP_PHASE == 0
            norm_mod_phase(F, (const GAS float*)0, (const GAS bf16*)XR, INP(F, 18) + (size_t)l * DM, cond_l, 3, 4, H);
#endif
            SEAM(pb + 7); }
        if (IN(pb + 8)) { OPQ();
            pg8::Gemm g{H, (const GAS bf16*)(wl + W_F1), MROWS, DFF, DM, DM, DM}; pg8::StaticOrder S; S.init(F.nb * (SEQ / 256), DFF, F.nl, F.rk, F.b0 * (SEQ / 256));
            pg8::EpiFf1 E{A1};
            pg8::gemm_phase<pg8::EpiFf1, pg8::StaticOrder, true, true>(F.lds, g, S, E, F.wave);
            SEAM(pb + 8);
        }
        if (IN(pb + 9)) { OPQ();
            pg8::Gemm g{A1, (const GAS bf16*)(wl + W_F2), MROWS, DM, DFF, DFF, DFF}; pg8::StaticOrder S; S.init(F.nb * (SEQ / 256), DM, F.nl, F.rk, F.b0 * (SEQ / 256));
            pg8::EpiRes E{(const GAS float*)0, (GAS bf16*)XR, cond_l + 5 * DM};
            pg8::gemm_phase<pg8::EpiRes, pg8::StaticOrder, true, true>(F.lds, g, S, E, F.wave);
            SEAM(pb + 9);
        }
    }
    if (IN(NPHASES - 1)) { Frame F = F0; asm volatile("" : "+s"(F.wave), "+s"(F.vcu)); { unsigned ones_ = ~0u; asm volatile("" : "+s"(ones_)); F.lane = (int)__builtin_amdgcn_mbcnt_hi(ones_, __builtin_amdgcn_mbcnt_lo(ones_, 0u)); } F.tid = (F.wave << 6) | F.lane; asm volatile("" : "+v"(F.tid), "+v"(F.lane)); dom_load(F); final_norm_phase(F, (const GAS bf16*)F.out, INP(F, 21), F.out); }
#undef IN
#undef SEAM
}


#ifdef PROBE_N
__global__ void dump_k(const unsigned char* ws, float* out, int mode) {
    const size_t n = (size_t)MROWS * DM;
    for (size_t i = (size_t)blockIdx.x * blockDim.x + threadIdx.x; i < n; i += (size_t)gridDim.x * blockDim.x) {
        float v = 0.f;
        if (mode == 0) { v = bf2f(((const bf16*)(ws + WS_ZC))[i]) + bf2f(((const bf16*)(ws + WS_MG))[i]) + bf2f(((const bf16*)(ws + WS_Q))[i % ((size_t)MROWS * 512)]) + bf2f(((const bf16*)(ws + WS_KV))[i % ((size_t)MROWS * 768)]) + ((const float*)(ws + WS_NG))[i % ((size_t)MROWS * 24)]; }
        else if (mode == 1) { v = bf2f(((const bf16*)(ws + WS_CVAO))[i]) + bf2f(((const bf16*)(ws + WS_KCMP))[i % (size_t)(BATCH * 2 * 128 * 64)]) + bf2f(((const bf16*)(ws + WS_VCMP))[i % (size_t)(BATCH * 2 * 128 * 64)]); }
        else if (mode == 2) { v = bf2f(((const bf16*)(ws + WS_U))[i]); }
        else if (mode == 3) { v = out[i]; }
        else if (mode == 4) { v = bf2f(((const bf16*)(ws + WS_H))[i]); }
        else if (mode == 5) { v = bf2f(((const bf16*)(ws + WS_A1))[i]) + bf2f(((const bf16*)(ws + WS_A1))[i + n]) + bf2f(((const bf16*)(ws + WS_A1))[i + 2 * n]) + bf2f(((const bf16*)(ws + WS_A1))[i + 3 * n]); }
        out[i] = v;
    }
}
#endif
extern "C" void kernel_launch(void* const* d_in, const int* in_sizes, int n_in, void* d_out, int out_size, void* d_ws, size_t ws_size, hipStream_t stream) {
    static int grid = 0;
    if (grid == 0) {
        if (n_in != 22 || out_size != MROWS * DM || ws_size < WS_END) { fprintf(stderr, "kernel_launch: unexpected shapes (n_in %d out %d ws %zu need %zu)\n", n_in, out_size, ws_size, (size_t)WS_END); grid = -1; return; }
        int dev = 0, cus = 0, per_cu = 0;
        if (hipGetDevice(&dev) != hipSuccess || hipDeviceGetAttribute(&cus, hipDeviceAttributeMultiprocessorCount, dev) != hipSuccess) { grid = -1; return; }
        if (hipFuncSetAttribute((const void*)fwd, hipFuncAttributeMaxDynamicSharedMemorySize, LDS_BYTES) != hipSuccess) { fprintf(stderr, "kernel_launch: hipFuncSetAttribute failed\n"); grid = -1; return; }
        if (hipOccupancyMaxActiveBlocksPerMultiprocessor(&per_cu, (const void*)fwd, NWAVES * 64, LDS_BYTES) != hipSuccess || per_cu < 1)
            fprintf(stderr, "kernel_launch: occupancy query reports %d workgroups per CU\n", per_cu);
        (void)hipGetLastError();
        grid = cus;
    }
    if (grid < 0) return;
    if (hipMemsetAsync((char*)d_ws + WS_CTL, 0, CTL_ZERO_BYTES, stream) != hipSuccess) return;
    Args a{};
    for (int i = 0; i < 22; ++i) a.in[i] = (const float*)d_in[i];
    a.out = (float*)d_out; a.ws = (unsigned char*)d_ws;
#if MK_SINGLE
    a.ph_lo = 0; a.ph_hi = NPHASES;
    hipLaunchKernelGGL(fwd, dim3(grid), dim3(NWAVES * 64), LDS_BYTES, stream, a);
#else
#ifdef PROBE_N
    for (int p = 0; p < PROBE_N; ++p) { a.ph_lo = p; a.ph_hi = p + 1; hipLaunchKernelGGL(fwd, dim3(grid), dim3(NWAVES * 64), LDS_BYTES, stream, a); }
    hipLaunchKernelGGL(dump_k, dim3(2048), dim3(256), 0, stream, (const unsigned char*)d_ws, (float*)d_out, PROBE_MODE);
#else
    for (int p = 0; p < NPHASES; ++p) { a.ph_lo = p; a.ph_hi = p + 1; hipLaunchKernelGGL(fwd, dim3(grid), dim3(NWAVES * 64), LDS_BYTES, stream, a); }
#endif
#endif
}
```
